# Optimizing an MI355X kernel written in HIP

```python
import jax
import jax.numpy as jnp
from jax import lax
import numpy as np

D_MODEL = 1024
BATCH = 2
SEQ = 8192
DEPTH = 1

CHUNK = 64
RWKV_HEADS = 8
RWKV_HEAD_DIM = 64
RWKV_WIDTH = RWKV_HEADS * RWKV_HEAD_DIM
DECAY_LORA = 64
AAA_LORA = 64
GATE_LORA = 160
GMLP_GROUPS = 4
GMLP_GROUP_DIM = 128
GMLP_WIDTH = GMLP_GROUPS * GMLP_GROUP_DIM
GMLP_BLOCK = 128
FFN_HIDDEN = -(-8 * D_MODEL // (3 * 256)) * 256
RWKV_SHIFT_COLS = 3 * RWKV_WIDTH + DECAY_LORA + AAA_LORA + GATE_LORA
IN_COLS = RWKV_SHIFT_COLS + 2 * GMLP_WIDTH + 2 * D_MODEL
N_MOD = 6
NORM_EPS = 1e-6
LN_EPS = 1e-5
LNX_EPS = 64e-5

kernel_name = 'hybrid_rwkv7_gmlp_adaln_block'


def _f32(t):
    return t.astype(jnp.float32)


def _rmsnorm(x, g):
    x32 = _f32(x)
    y = x32 * lax.rsqrt(jnp.mean(x32 * x32, axis=-1, keepdims=True) + NORM_EPS)
    return y.astype(x.dtype) * g


def _modulate(h, shift, scale):
    return h * (1 + scale[:, None, :]) + shift[:, None, :]


def _token_shift(p):
    return jnp.pad(p, ((0, 0), (1, 0), (0, 0)))[:, :-1, :]


def _rwkv7_scan(r, w, k, v, kk, a):
    b, s, h, n = r.shape

    def step(state, inp):
        r_t, w_t, k_t, v_t, kk_t, a_t = inp
        sa = jnp.einsum('bhvk,bhk->bhv', state, -kk_t)
        state = (state * w_t[:, :, None, :]
                 + sa[..., None] * (kk_t * a_t)[:, :, None, :]
                 + v_t[..., None] * k_t[:, :, None, :])
        y = jnp.einsum('bhvk,bhk->bhv', state, r_t)
        return state, y

    s0 = jnp.zeros((b, h, n, n), jnp.float32)
    xs = tuple(jnp.swapaxes(t, 0, 1) for t in (r, w, k, v, kk, a))
    _, ys = lax.scan(step, s0, xs)
    return jnp.swapaxes(ys, 0, 1)


def _rwkv7_branch(p_shift, mu, w0, w_decay_up, a0, w_aaa_up, w_gate_up,
                  k_k, k_a, r_k, lnx_g, lnx_b):
    b, s, _ = p_shift.shape
    xs = _f32(p_shift + (_token_shift(p_shift) - p_shift) * mu)
    split_at = [RWKV_WIDTH, 2 * RWKV_WIDTH, 3 * RWKV_WIDTH,
                3 * RWKV_WIDTH + DECAY_LORA, 3 * RWKV_WIDTH + DECAY_LORA + AAA_LORA]
    r, k, v, wd, ad, gd = jnp.split(xs, split_at, axis=-1)
    w_log = -jax.nn.softplus(-(_f32(w0) + jnp.tanh(wd) @ _f32(w_decay_up))) - 0.5
    decay = jnp.exp(-jnp.exp(w_log))
    a = jax.nn.sigmoid(_f32(a0) + ad @ _f32(w_aaa_up))
    g = jax.nn.sigmoid(gd) @ _f32(w_gate_up)

    def heads(t):
        return t.reshape(b, s, RWKV_HEADS, RWKV_HEAD_DIM)

    kk = heads(k * _f32(k_k))
    kk = kk / jnp.maximum(jnp.sqrt(jnp.sum(kk * kk, axis=-1, keepdims=True)), 1e-12)
    k = k * (1 + (a - 1) * _f32(k_a))
    rh, kh, vh, wh, ah = heads(r), heads(k), heads(v), heads(decay), heads(a)
    y = _rwkv7_scan(rh, wh, kh, vh, kk, ah)
    mean = jnp.mean(y, axis=-1, keepdims=True)
    var = jnp.mean(jnp.square(y - mean), axis=-1, keepdims=True)
    y = ((y - mean) * lax.rsqrt(var + LNX_EPS)).reshape(b, s, RWKV_WIDTH) * _f32(lnx_g) + _f32(lnx_b)
    bonus = jnp.sum(rh * kh * _f32(r_k), axis=-1, keepdims=True) * vh
    y = (y + bonus.reshape(b, s, RWKV_WIDTH)) * g
    return y.astype(p_shift.dtype)


def _gmlp_branch(p_uv, ln_g, ln_b, w_s, b_s):
    b, s, _ = p_uv.shape
    u, v = jnp.split(jax.nn.gelu(p_uv, approximate=False), 2, axis=-1)
    v32 = _f32(v)
    mean = jnp.mean(v32, axis=-1, keepdims=True)
    var = jnp.mean(jnp.square(v32 - mean), axis=-1, keepdims=True)
    v = ((v32 - mean) * lax.rsqrt(var + LN_EPS)).astype(p_uv.dtype) * ln_g + ln_b
    nb = s // GMLP_BLOCK
    vb = v.reshape(b, nb, GMLP_BLOCK, GMLP_GROUPS, GMLP_GROUP_DIM)
    pos = jnp.arange(GMLP_BLOCK)
    mask = (pos[None, :] // CHUNK) <= (pos[:, None] // CHUNK)
    ws = jnp.where(mask[None], w_s, 0)
    sv = jnp.einsum('gij,bnjgd->bnigd', ws, vb) + b_s.T[None, None, :, :, None]
    return u * sv.reshape(b, s, GMLP_WIDTH)


def setup_inputs(seed: int = 0) -> dict:
    key = jax.random.key(seed)
    ks = jax.random.split(key, 32)
    L, D = DEPTH, D_MODEL

    def nrm(k, shape, scale):
        return scale * jax.random.normal(k, shape, jnp.float32)

    def uni(k, shape, lo, hi):
        return jax.random.uniform(k, shape, jnp.float32, lo, hi)

    return {
        'x': nrm(ks[0], (BATCH, SEQ, D), 1.0),
        'c': nrm(ks[1], (BATCH, D), 1.0),
        'w_ada': nrm(ks[2], (L, D, N_MOD * D), 0.5 * D ** -0.5),
        'b_ada': nrm(ks[3], (L, N_MOD * D), 0.02),
        'norm1_g': 1.0 + nrm(ks[4], (L, D), 0.02),
        'norm2_g': 1.0 + nrm(ks[5], (L, D), 0.02),
        'normf_g': 1.0 + nrm(ks[6], (D,), 0.02),
        'w_in': nrm(ks[7], (L, D, IN_COLS), D ** -0.5),
        'mu_shift': uni(ks[8], (L, RWKV_SHIFT_COLS), 0.0, 1.0),
        'w0': uni(ks[9], (L, RWKV_WIDTH), -6.5, -1.5),
        'w_decay_up': nrm(ks[10], (L, DECAY_LORA, RWKV_WIDTH), DECAY_LORA ** -0.5),
        'a0': nrm(ks[11], (L, RWKV_WIDTH), 0.1),
        'w_aaa_up': nrm(ks[12], (L, AAA_LORA, RWKV_WIDTH), AAA_LORA ** -0.5),
        'w_gate_up': nrm(ks[13], (L, GATE_LORA, RWKV_WIDTH), GATE_LORA ** -0.5),
        'k_k': 0.85 + nrm(ks[14], (L, RWKV_WIDTH), 0.05),
        'k_a': 1.0 + nrm(ks[15], (L, RWKV_WIDTH), 0.05),
        'r_k': nrm(ks[16], (L, RWKV_HEADS, RWKV_HEAD_DIM), 0.1),
        'lnx_g': 1.0 + nrm(ks[17], (L, RWKV_WIDTH), 0.02),
        'lnx_b': nrm(ks[18], (L, RWKV_WIDTH), 0.02),
        'gmlp_ln_g': 1.0 + nrm(ks[19], (L, GMLP_WIDTH), 0.02),
        'gmlp_ln_b': nrm(ks[20], (L, GMLP_WIDTH), 0.02),
        'w_spatial': nrm(ks[21], (L, GMLP_GROUPS, GMLP_BLOCK, GMLP_BLOCK), 0.5 * GMLP_BLOCK ** -0.5),
        'b_spatial': 1.0 + nrm(ks[22], (L, GMLP_GROUPS, GMLP_BLOCK), 0.1),
        'w_branch_a': nrm(ks[23], (L, RWKV_WIDTH, D), RWKV_WIDTH ** -0.5),
        'w_branch_b': nrm(ks[24], (L, GMLP_WIDTH, D), GMLP_WIDTH ** -0.5),
        'w_out': nrm(ks[25], (L, D, D), D ** -0.5),
        'w_ffn_in': nrm(ks[26], (L, D, 2 * FFN_HIDDEN), D ** -0.5),
        'w_ffn_out': nrm(ks[27], (L, FFN_HIDDEN, D), FFN_HIDDEN ** -0.5),
    }


def reference(x, c, w_ada, b_ada, norm1_g, norm2_g, normf_g, w_in, mu_shift, w0,
              w_decay_up, a0, w_aaa_up, w_gate_up, k_k, k_a, r_k, lnx_g, lnx_b,
              gmlp_ln_g, gmlp_ln_b, w_spatial, b_spatial, w_branch_a, w_branch_b,
              w_out, w_ffn_in, w_ffn_out):
    c_act = jax.nn.silu(c)
    for l in range(DEPTH):
        mod = c_act @ w_ada[l] + b_ada[l]
        sh1, sc1, gt1, sh2, sc2, gt2 = jnp.split(mod, N_MOD, axis=-1)

        h = _modulate(_rmsnorm(x, norm1_g[l]), sh1, sc1)
        p = h @ w_in[l]
        p_rwkv, p_gmlp, g_logits = jnp.split(
            p, [RWKV_SHIFT_COLS, RWKV_SHIFT_COLS + 2 * GMLP_WIDTH], axis=-1)
        gate_a, gate_b = jnp.split(g_logits, 2, axis=-1)
        ya = _rwkv7_branch(p_rwkv, mu_shift[l], w0[l], w_decay_up[l], a0[l], w_aaa_up[l],
                           w_gate_up[l], k_k[l], k_a[l], r_k[l], lnx_g[l], lnx_b[l])
        yb = _gmlp_branch(p_gmlp, gmlp_ln_g[l], gmlp_ln_b[l], w_spatial[l], b_spatial[l])
        merged = (jax.nn.sigmoid(gate_a) * (ya @ w_branch_a[l])
                  + jax.nn.sigmoid(gate_b) * (yb @ w_branch_b[l]))
        x = x + gt1[:, None, :] * (merged @ w_out[l])

        h2 = _modulate(_rmsnorm(x, norm2_g[l]), sh2, sc2)
        f_gate, f_up = jnp.split(h2 @ w_ffn_in[l], 2, axis=-1)
        x = x + gt2[:, None, :] * ((jax.nn.silu(f_gate) * f_up) @ w_ffn_out[l])
    return _rmsnorm(x, normf_g)
```

```cpp
#include <hip/hip_runtime.h>
#include <cstdint>
#include <cstdio>

namespace {
constexpr int BATCH = 2, SEQ = 8192, D = 1024, M = BATCH * SEQ;
constexpr int RW = 512, NH = 8, HD = 64, L_DEC = 64, L_AAA = 64, L_GATE = 160;
constexpr int GW = 512, GG = 4, GD = 128, GB = 128;
constexpr int FF = 2816;
constexpr int SHIFT_COLS = 3 * RW + L_DEC + L_AAA + L_GATE;
constexpr int IN_COLS = SHIFT_COLS + 2 * GW + 2 * D;
constexpr size_t MiB = 1u << 20;

typedef unsigned short bf16;
__device__ __forceinline__ float bf2f(bf16 v) { return __uint_as_float(((unsigned)v) << 16); }
__device__ __forceinline__ bf16 f2bf(float f) { unsigned u = __float_as_uint(f); return (bf16)((u + 0x7fffu + ((u >> 16) & 1u)) >> 16); }
__device__ __forceinline__ float sigmoidf_(float x) { return 1.f / (1.f + expf(-x)); }
__device__ __forceinline__ float siluf_(float x) { return x / (1.f + expf(-x)); }
__device__ __forceinline__ float geluf_(float x) { return 0.5f * x * (1.f + erff(x * 0.70710678118654752f)); }
__device__ __forceinline__ float softplusf_(float x) { return x > 20.f ? x : log1pf(expf(x)); }
__device__ __forceinline__ float wave_sum(float v) {
#pragma unroll
    for (int o = 1; o < 64; o <<= 1) v += __shfl_xor(v, o);
    return v;
}

__global__ void k_mod(const float* __restrict__ c, const float* __restrict__ w_ada, const float* __restrict__ b_ada, float* __restrict__ mod) {
    const int n = blockIdx.x * blockDim.x + threadIdx.x;
    if (n >= 6 * D) return;
    float a0 = 0.f, a1 = 0.f;
#pragma unroll 8
    for (int k = 0; k < D; ++k) { const float w = w_ada[(size_t)k * (6 * D) + n]; a0 += siluf_(c[k]) * w; a1 += siluf_(c[D + k]) * w; }
    mod[n] = a0 + b_ada[n]; mod[6 * D + n] = a1 + b_ada[n];
}

__global__ void k_rmsnorm_mod(const float* __restrict__ x, const float* __restrict__ g, const float* __restrict__ mod, int sh_off, int sc_off, bf16* __restrict__ out) {
    const int row = blockIdx.x * 4 + (threadIdx.x >> 6), lane = threadIdx.x & 63;
    const int b = row / SEQ;
    const float* xr = x + (size_t)row * D;
    float v[16]; float s = 0.f;
#pragma unroll
    for (int j = 0; j < 16; ++j) { v[j] = xr[lane + 64 * j]; s += v[j] * v[j]; }
    const float rstd = 1.0f / sqrtf(wave_sum(s) * (1.f / D) + 1e-6f);
    const float* sh = mod + b * 6 * D + sh_off; const float* sc = mod + b * 6 * D + sc_off;
#pragma unroll
    for (int j = 0; j < 16; ++j) { const int cidx = lane + 64 * j; const float y = v[j] * rstd * g[cidx]; out[(size_t)row * D + cidx] = f2bf(y * (1.f + sc[cidx]) + sh[cidx]); }
}

__global__ void k_rmsnorm_final(float* __restrict__ x, const float* __restrict__ g) {
    const int row = blockIdx.x * 4 + (threadIdx.x >> 6), lane = threadIdx.x & 63;
    float* xr = x + (size_t)row * D;
    float v[16]; float s = 0.f;
#pragma unroll
    for (int j = 0; j < 16; ++j) { v[j] = xr[lane + 64 * j]; s += v[j] * v[j]; }
    const float rstd = 1.0f / sqrtf(wave_sum(s) * (1.f / D) + 1e-6f);
#pragma unroll
    for (int j = 0; j < 16; ++j) xr[lane + 64 * j] = v[j] * rstd * g[lane + 64 * j];
}

struct GemmArgs { const bf16* A; const float* W; int K, ldw, c0, c1, N; void* out; int ldo; const bf16* aux; int ldaux; const bf16* aux2; int ldaux2; const float* res; const float* gate; };
template <int EPI>
__global__ void __launch_bounds__(256) k_gemm_naive(GemmArgs g) {
    constexpr bool DUAL = (EPI == 6);
    __shared__ float As[16][65];
    __shared__ float Bs[16][64];
    __shared__ float Bs2[DUAL ? 16 : 1][64];
    const int tx = threadIdx.x & 15, ty = threadIdx.x >> 4;
    const int row0 = blockIdx.y * 64, col0 = blockIdx.x * 64;
    float acc[4][4] = {}, acc2[4][4] = {};
    for (int k0 = 0; k0 < g.K; k0 += 16) {
        for (int i = threadIdx.x; i < 64 * 16; i += 256) { const int r = i >> 4, kk = i & 15; As[kk][r] = bf2f(g.A[(size_t)(row0 + r) * g.K + k0 + kk]); }
        for (int i = threadIdx.x; i < 16 * 64; i += 256) { const int kk = i >> 6, cc = i & 63; const int col = col0 + cc;
            Bs[kk][cc] = col < g.N ? g.W[(size_t)(k0 + kk) * g.ldw + g.c0 + col] : 0.f;
            if (DUAL) Bs2[kk][cc] = col < g.N ? g.W[(size_t)(k0 + kk) * g.ldw + g.c1 + col] : 0.f; }
        __syncthreads();
#pragma unroll
        for (int kk = 0; kk < 16; ++kk) {
            float a[4], b[4], b2[4];
#pragma unroll
            for (int i = 0; i < 4; ++i) { a[i] = As[kk][ty * 4 + i]; b[i] = Bs[kk][tx * 4 + i]; if (DUAL) b2[i] = Bs2[kk][tx * 4 + i]; }
#pragma unroll
            for (int i = 0; i < 4; ++i)
#pragma unroll
                for (int j = 0; j < 4; ++j) { acc[i][j] += a[i] * b[j]; if (DUAL) acc2[i][j] += a[i] * b2[j]; }
        }
        __syncthreads();
    }
#pragma unroll
    for (int i = 0; i < 4; ++i)
#pragma unroll
        for (int j = 0; j < 4; ++j) {
            const int row = row0 + ty * 4 + i, col = col0 + tx * 4 + j;
            if (col >= g.N) continue;
            const float v = acc[i][j];
            const size_t o = (size_t)row * g.ldo + col;
            if (EPI == 0) ((bf16*)g.out)[o] = f2bf(v);
            else if (EPI == 1) ((bf16*)g.out)[o] = f2bf(geluf_(v));
            else if (EPI == 2) ((bf16*)g.out)[o] = f2bf(sigmoidf_(v));
            else if (EPI == 3) ((bf16*)g.out)[o] = f2bf(bf2f(g.aux[(size_t)row * g.ldaux + col]) * v);
            else if (EPI == 4) ((bf16*)g.out)[o] = f2bf(bf2f(g.aux[(size_t)row * g.ldaux + col]) * v + bf2f(g.aux2[(size_t)row * g.ldaux2 + col]));
            else if (EPI == 5) { const int b = row / SEQ; ((float*)g.out)[o] = g.res[o] + g.gate[b * 6 * D + col] * v; }
            else if (EPI == 6) ((bf16*)g.out)[o] = f2bf(siluf_(v) * acc2[i][j]);
        }
}

struct PrepArgs { const bf16* Prkv; const bf16* Plora; const float *mu, *w0, *wdu, *a0, *wau, *wgu, *k_k, *k_a, *r_k;
                  bf16 *R, *K, *V, *KK, *A, *G, *BON; float* LW; };
__global__ void __launch_bounds__(512) k_rwkv_prep(PrepArgs p) {
    __shared__ float lin[8][288];
    const int c = threadIdx.x, t0 = blockIdx.x * 8;
    for (int i = threadIdx.x; i < 8 * 288; i += 512) {
        const int tt = i / 288, j = i % 288, t = t0 + tt;
        const float cur = bf2f(p.Plora[(size_t)t * 512 + j]);
        const float prev = (t % SEQ) == 0 ? 0.f : bf2f(p.Plora[(size_t)(t - 1) * 512 + j]);
        const float xs = cur + (prev - cur) * p.mu[1536 + j];
        lin[tt][j] = j < 64 ? tanhf(xs) : (j < 128 ? xs : sigmoidf_(xs));
    }
    __syncthreads();
    float dw[8] = {}, da[8] = {}, dg[8] = {};
    for (int j = 0; j < 64; ++j) { const float w = p.wdu[j * 512 + c];
#pragma unroll
        for (int tt = 0; tt < 8; ++tt) dw[tt] += lin[tt][j] * w; }
    for (int j = 0; j < 64; ++j) { const float w = p.wau[j * 512 + c];
#pragma unroll
        for (int tt = 0; tt < 8; ++tt) da[tt] += lin[tt][64 + j] * w; }
    for (int j = 0; j < 160; ++j) { const float w = p.wgu[j * 512 + c];
#pragma unroll
        for (int tt = 0; tt < 8; ++tt) dg[tt] += lin[tt][128 + j] * w; }
    for (int tt = 0; tt < 8; ++tt) {
        const int t = t0 + tt; const bool first = (t % SEQ) == 0;
        float xs[3];
#pragma unroll
        for (int q = 0; q < 3; ++q) { const float cur = bf2f(p.Prkv[(size_t)t * 1536 + q * 512 + c]); const float prev = first ? 0.f : bf2f(p.Prkv[(size_t)(t - 1) * 1536 + q * 512 + c]);
            xs[q] = cur + (prev - cur) * p.mu[q * 512 + c]; }
        const float r = xs[0], k = xs[1], v = xs[2];
        const float wlog = -softplusf_(-(p.w0[c] + dw[tt])) - 0.5f;
        const float lw = -expf(wlog);
        const float a = sigmoidf_(p.a0[c] + da[tt]);
        float kk = k * p.k_k[c];
        const float nrm = sqrtf(wave_sum(kk * kk));
        kk = kk / fmaxf(nrm, 1e-12f);
        const float k2 = k * (1.f + (a - 1.f) * p.k_a[c]);
        const float bon = wave_sum(r * k2 * p.r_k[c]) * v;
        const size_t o = (size_t)t * 512 + c;
        p.R[o] = f2bf(r); p.K[o] = f2bf(k2); p.V[o] = f2bf(v); p.KK[o] = f2bf(kk); p.A[o] = f2bf(a); p.LW[o] = lw; p.G[o] = f2bf(dg[tt]); p.BON[o] = f2bf(bon);
    }
}

struct ScanArgs { const bf16 *R, *K, *V, *KK, *A; const float* LW; float* Y; };
__global__ void __launch_bounds__(256) k_scan_naive(ScanArgs p) {
    const int wave = blockIdx.x * 4 + (threadIdx.x >> 6), lane = threadIdx.x & 63;
    const int vrow = wave & 63, h = (wave >> 6) & 7, b = wave >> 9;
    float S = 0.f;
    const size_t base = (size_t)b * SEQ * 512 + h * 64;
    for (int t0 = 0; t0 < SEQ; t0 += 8) {
        float r[8], k[8], kk[8], a[8], w[8], vv[8];
#pragma unroll
        for (int i = 0; i < 8; ++i) { const size_t o = base + (size_t)(t0 + i) * 512 + lane;
            r[i] = bf2f(p.R[o]); k[i] = bf2f(p.K[o]); kk[i] = bf2f(p.KK[o]); a[i] = bf2f(p.A[o]); w[i] = expf(p.LW[o]); vv[i] = bf2f(p.V[base + (size_t)(t0 + i) * 512 + vrow]); }
#pragma unroll
        for (int i = 0; i < 8; ++i) {
            const float sa = wave_sum(S * (-kk[i]));
            S = S * w[i] + sa * (kk[i] * a[i]) + vv[i] * k[i];
            const float y = wave_sum(S * r[i]);
            if (lane == 0) p.Y[base + (size_t)(t0 + i) * 512 + vrow] = y;
        }
    }
}

__global__ void k_rwkv_fin(const float* __restrict__ Y, const bf16* __restrict__ G, const bf16* __restrict__ BON, const float* __restrict__ lnx_g, const float* __restrict__ lnx_b, bf16* __restrict__ YA) {
    const int wave = blockIdx.x * 4 + (threadIdx.x >> 6), lane = threadIdx.x & 63;
    const int t = wave >> 3, h = wave & 7, c = h * 64 + lane;
    const size_t o = (size_t)t * 512 + c;
    const float y = Y[o];
    const float mean = wave_sum(y) * (1.f / 64.f);
    const float d = y - mean;
    const float var = wave_sum(d * d) * (1.f / 64.f);
    const float yn = d * (1.0f / sqrtf(var + 64e-5f)) * lnx_g[c] + lnx_b[c];
    YA[o] = f2bf((yn + bf2f(BON[o])) * bf2f(G[o]));
}

__global__ void __launch_bounds__(256) k_gmlp(const bf16* __restrict__ Puv, const float* __restrict__ ln_g, const float* __restrict__ ln_b, const float* __restrict__ w_s, const float* __restrict__ b_s, bf16* __restrict__ YB) {
    extern __shared__ float vn[];
    __shared__ float mean_s[128], rstd_s[128];
    const int g = blockIdx.x & 3, blk = blockIdx.x >> 2;
    const int row0 = blk * 128;
    const int wave = threadIdx.x >> 6, lane = threadIdx.x & 63;
    for (int r = wave; r < 128; r += 4) {
        const bf16* vr = Puv + (size_t)(row0 + r) * 1024 + 512;
        float s = 0.f, v[8];
#pragma unroll
        for (int j = 0; j < 8; ++j) { v[j] = bf2f(vr[lane + 64 * j]); s += v[j]; }
        const float mean = wave_sum(s) * (1.f / 512.f);
        float q = 0.f;
#pragma unroll
        for (int j = 0; j < 8; ++j) { const float d = v[j] - mean; q += d * d; }
        const float var = wave_sum(q) * (1.f / 512.f);
        if (lane == 0) { mean_s[r] = mean; rstd_s[r] = 1.0f / sqrtf(var + 1e-5f); }
    }
    __syncthreads();
    for (int i = threadIdx.x; i < 128 * 128; i += 256) { const int r = i >> 7, d = i & 127; const int ch = g * 128 + d;
        vn[i] = (bf2f(Puv[(size_t)(row0 + r) * 1024 + 512 + ch]) - mean_s[r]) * rstd_s[r] * ln_g[ch] + ln_b[ch]; }
    __syncthreads();
    const int d = threadIdx.x & 127;
    for (int i = threadIdx.x >> 7; i < 128; i += 2) {
        const float* wrow = w_s + ((size_t)g * 128 + i) * 128;
        const int jmax = i < 64 ? 64 : 128;
        float acc = 0.f;
        for (int j = 0; j < jmax; ++j) acc += wrow[j] * vn[j * 128 + d];
        acc += b_s[g * 128 + i];
        const float u = bf2f(Puv[(size_t)(row0 + i) * 1024 + g * 128 + d]);
        YB[(size_t)(row0 + i) * 512 + g * 128 + d] = f2bf(u * acc);
    }
}
}

extern "C" void kernel_launch(void* const* d_in, const int* in_sizes, int n_in, void* d_out, int out_size, void* d_ws, size_t ws_size, hipStream_t stream) {
    const float* x = (const float*)d_in[0]; const float* c = (const float*)d_in[1]; const float* w_ada = (const float*)d_in[2]; const float* b_ada = (const float*)d_in[3];
    const float* norm1_g = (const float*)d_in[4]; const float* norm2_g = (const float*)d_in[5]; const float* normf_g = (const float*)d_in[6]; const float* w_in = (const float*)d_in[7];
    const float* mu = (const float*)d_in[8]; const float* w0 = (const float*)d_in[9]; const float* wdu = (const float*)d_in[10]; const float* a0 = (const float*)d_in[11];
    const float* wau = (const float*)d_in[12]; const float* wgu = (const float*)d_in[13]; const float* k_k = (const float*)d_in[14]; const float* k_a = (const float*)d_in[15];
    const float* r_k = (const float*)d_in[16]; const float* lnx_g = (const float*)d_in[17]; const float* lnx_b = (const float*)d_in[18]; const float* gln_g = (const float*)d_in[19];
    const float* gln_b = (const float*)d_in[20]; const float* w_sp = (const float*)d_in[21]; const float* b_sp = (const float*)d_in[22]; const float* w_ba = (const float*)d_in[23];
    const float* w_bb = (const float*)d_in[24]; const float* w_out = (const float*)d_in[25]; const float* w_fi = (const float*)d_in[26]; const float* w_fo = (const float*)d_in[27];
    unsigned char* ws = (unsigned char*)d_ws; float* out = (float*)d_out;
    float* mod = (float*)(ws + 0);
    bf16* H = (bf16*)(ws + 2 * MiB);
    bf16* Prkv = (bf16*)(ws + 34 * MiB); bf16* Plora = (bf16*)(ws + 82 * MiB); bf16* Puv = (bf16*)(ws + 98 * MiB); bf16* SG = (bf16*)(ws + 130 * MiB);
    bf16* R = (bf16*)(ws + 194 * MiB); bf16* K = (bf16*)(ws + 210 * MiB); bf16* V = (bf16*)(ws + 226 * MiB);
    bf16* KK = (bf16*)((unsigned char*)d_out); bf16* A = (bf16*)((unsigned char*)d_out + 16 * MiB); float* LW = (float*)((unsigned char*)d_out + 32 * MiB);
    bf16* G = (bf16*)(ws + 2 * MiB); bf16* BON = (bf16*)(ws + 18 * MiB);
    float* Y = (float*)(ws + 34 * MiB); bf16* YA = (bf16*)(ws + 66 * MiB); bf16* YB = (bf16*)(ws + 82 * MiB);
    bf16* M1 = (bf16*)(ws + 98 * MiB); bf16* MERGED = (bf16*)(ws + 2 * MiB);
    bf16* H2 = (bf16*)(ws + 34 * MiB); bf16* ACT = (bf16*)(ws + 98 * MiB);

    k_mod<<<6 * D / 256, 256, 0, stream>>>(c, w_ada, b_ada, mod);
    k_rmsnorm_mod<<<M / 4, 256, 0, stream>>>(x, norm1_g, mod, 0, D, H);
    { GemmArgs g{}; g.A = H; g.W = w_in; g.K = D; g.ldw = IN_COLS;
      g.c0 = 0; g.N = 1536; g.out = Prkv; g.ldo = 1536; k_gemm_naive<0><<<dim3(1536 / 64, M / 64), 256, 0, stream>>>(g);
      g.c0 = 1536; g.N = 288; g.out = Plora; g.ldo = 512; k_gemm_naive<0><<<dim3(5, M / 64), 256, 0, stream>>>(g);
      g.c0 = 1824; g.N = 1024; g.out = Puv; g.ldo = 1024; k_gemm_naive<1><<<dim3(1024 / 64, M / 64), 256, 0, stream>>>(g);
      g.c0 = 2848; g.N = 2048; g.out = SG; g.ldo = 2048; k_gemm_naive<2><<<dim3(2048 / 64, M / 64), 256, 0, stream>>>(g); }
    { PrepArgs p{Prkv, Plora, mu, w0, wdu, a0, wau, wgu, k_k, k_a, r_k, R, K, V, KK, A, G, BON, LW};
      k_rwkv_prep<<<M / 8, 512, 0, stream>>>(p); }
    { ScanArgs p{R, K, V, KK, A, LW, Y}; k_scan_naive<<<BATCH * NH * HD / 4, 256, 0, stream>>>(p); }
    k_rwkv_fin<<<M * NH / 4, 256, 0, stream>>>(Y, G, BON, lnx_g, lnx_b, YA);
    (void)hipFuncSetAttribute((const void*)k_gmlp, hipFuncAttributeMaxDynamicSharedMemorySize, 128 * 128 * 4);
    k_gmlp<<<(M / 128) * 4, 256, 128 * 128 * 4, stream>>>(Puv, gln_g, gln_b, w_sp, b_sp, YB);
    { GemmArgs g{}; g.A = YB; g.W = w_bb; g.K = 512; g.ldw = D; g.c0 = 0; g.N = D; g.out = M1; g.ldo = D; g.aux = SG + 1024; g.ldaux = 2048;
      k_gemm_naive<3><<<dim3(D / 64, M / 64), 256, 0, stream>>>(g); }
    { GemmArgs g{}; g.A = YA; g.W = w_ba; g.K = 512; g.ldw = D; g.c0 = 0; g.N = D; g.out = MERGED; g.ldo = D; g.aux = SG; g.ldaux = 2048; g.aux2 = M1; g.ldaux2 = D;
      k_gemm_naive<4><<<dim3(D / 64, M / 64), 256, 0, stream>>>(g); }
    { GemmArgs g{}; g.A = MERGED; g.W = w_out; g.K = D; g.ldw = D; g.c0 = 0; g.N = D; g.out = out; g.ldo = D; g.res = x; g.gate = mod + 2 * D;
      k_gemm_naive<5><<<dim3(D / 64, M / 64), 256, 0, stream>>>(g); }
    k_rmsnorm_mod<<<M / 4, 256, 0, stream>>>(out, norm2_g, mod, 3 * D, 4 * D, H2);
    { GemmArgs g{}; g.A = H2; g.W = w_fi; g.K = D; g.ldw = 2 * FF; g.c0 = 0; g.c1 = FF; g.N = FF; g.out = ACT; g.ldo = FF;
      k_gemm_naive<6><<<dim3(FF / 64, M / 64), 256, 0, stream>>>(g); }
    { GemmArgs g{}; g.A = ACT; g.W = w_fo; g.K = FF; g.ldw = D; g.c0 = 0; g.N = D; g.out = out; g.ldo = D; g.res = out; g.gate = mod + 5 * D;
      k_gemm_naive<5><<<dim3(D / 64, M / 64), 256, 0, stream>>>(g); }
    k_rmsnorm_final<<<M / 4, 256, 0, stream>>>(out, normf_g);
}
```

```cpp
#include <hip/hip_runtime.h>
#include <cstdio>
#include <cstdint>
namespace pg8 {
#define PG8_LAS __attribute__((address_space(3)))
typedef unsigned short bf16_t;
typedef short bf16x8 __attribute__((ext_vector_type(8)));
typedef float f32x4 __attribute__((ext_vector_type(4)));
typedef unsigned u32x4 __attribute__((ext_vector_type(4)));
constexpr int BM = 256, BK = 64, HALF = 128, HTB = HALF * BK * 2  , STAGE_BYTES = 8 * HTB, NXCD = 8, WGM = 8;

__host__ __device__ __forceinline__ int lds_byte(int r, int c) { const int st = (r >> 4) * 2 + (c >> 5), rr = r & 15, cc = c & 31, ob = rr * 64 + cc * 2; return st * 1024 + (ob ^ (((ob >> 9) & 1) << 5)); }
__host__ __device__ __forceinline__ void stage_rc(int b, int& R, int& C) { const int st = b / 1024, sb = b % 1024, swz = sb ^ (((sb >> 9) & 1) << 5); R = (st >> 1) * 16 + swz / 64; C = (st & 1) * 32 + (swz % 64) / 2; }
__host__ __device__ __forceinline__ int perm32(int rho) { const int n = rho >> 4, i = rho & 15; return 8 * (i >> 2) + 4 * n + (i & 3); }

struct Unit { int pm, pn; };
struct Gemm { const bf16_t* A; const bf16_t* Bt; int M, N, K; };

struct StaticOrder {
    int nM, nN, nwg, G, c;
    __host__ __device__ void init(int M, int N, int G_, int c_) { nM = M / BM; nN = N / BM; nwg = nM * nN; G = G_; c = c_; }
    __host__ __device__ bool next(int i, Unit& u) const {
        const long L = (long)i * G + c; if (L >= nwg) return false;
        int wgid = (int)L; { const int q = nwg / NXCD, r = nwg % NXCD, xcd = wgid % NXCD, off = wgid / NXCD; wgid = (xcd < r ? xcd * (q + 1) : r * (q + 1) + (xcd - r) * q) + off; }
        const int nig = WGM * nN, gid = wgid / nig, fm = gid * WGM, gsz = (nM - fm) < WGM ? (nM - fm) : WGM;
        u.pm = fm + ((wgid % nig) % gsz); u.pn = (wgid % nig) / gsz; return true;
    }
    __device__ __forceinline__ void a_ready(const Unit&) const {}
    __device__ __forceinline__ void done(const Unit&) const {}
};

__device__ __forceinline__ unsigned cvt_pk_bf16(float lo, float hi) { unsigned r; asm volatile("v_cvt_pk_bf16_f32 %0, %1, %2" : "=v"(r) : "v"(lo), "v"(hi)); return r; }
typedef float f32x2 __attribute__((ext_vector_type(2)));
__device__ __forceinline__ f32x2 gelu_pk(f32x2 v) {
    const f32x2 av = __builtin_elementwise_abs(v), d = av * 0.2316418882f + 1.0f;
    f32x2 t; t.x = __builtin_amdgcn_rcpf(d.x); t.y = __builtin_amdgcn_rcpf(d.y);
    f32x2 q = t * 0.5307027145f + (-0.7265760135f); q = q * t + 0.7107068705f; q = q * t + (-0.142248368f); q = q * t + 0.127414796f; q = q * t;
    const f32x2 s = (v * v) * (-0.72134752044f);
    f32x2 e; e.x = __builtin_amdgcn_exp2f(s.x); e.y = __builtin_amdgcn_exp2f(s.y);
    const f32x2 m = v * (q * e), r = v - m;
    f32x2 o; o.x = v.x < 0.f ? m.x : r.x; o.y = v.y < 0.f ? m.y : r.y; return o;
}

__device__ __forceinline__ float fast_sigmoid(float x) { return __builtin_amdgcn_rcpf(1.f + __builtin_amdgcn_exp2f(-1.44269504089f * x)); }
__device__ __forceinline__ float bflo(unsigned w) { return __uint_as_float(w << 16); }
__device__ __forceinline__ float bfhi(unsigned w) { return __uint_as_float(w & 0xffff0000u); }
struct EpiIn {
    static constexpr bool PERM = true, AFTER_DRAIN = false;
    bf16_t *Prkv, *Plora, *Puv, *SG;
    __device__ __forceinline__ void operator()(const f32x4 (&acc)[2][2][4][2], const Unit& u, int wr, int wc, int fr, int fq) const {
        const int row0 = u.pm * BM + wr * 64 + fr;
        bf16_t* base; int ld, colt, act;
        if (u.pn < 6) { base = Prkv; ld = 1536; colt = u.pn * 256; act = 0; }
        else if (u.pn < 8) { base = Plora; ld = 512; colt = (u.pn - 6) * 256; act = 0; }
        else if (u.pn < 12) { base = Puv; ld = 1024; colt = (u.pn - 8) * 256; act = 1; }
        else { base = SG; ld = 2048; colt = (u.pn - 12) * 256; act = 2; }
        const int col0 = colt + wc * 32 + 8 * fq;
#pragma unroll
        for (int ai = 0; ai < 2; ++ai)
#pragma unroll
            for (int m = 0; m < 4; ++m) { bf16_t* rowp = base + (size_t)(row0 + ai * HALF + m * 16) * ld + col0;
#pragma unroll
                for (int bj = 0; bj < 2; ++bj) { f32x4 v0 = acc[ai][bj][m][0], v1 = acc[ai][bj][m][1];
                    if (act == 1) { f32x2 a = gelu_pk((f32x2){v0[0], v0[1]}), b = gelu_pk((f32x2){v0[2], v0[3]}), c = gelu_pk((f32x2){v1[0], v1[1]}), d = gelu_pk((f32x2){v1[2], v1[3]});
                        v0 = (f32x4){a.x, a.y, b.x, b.y}; v1 = (f32x4){c.x, c.y, d.x, d.y}; }
                    else if (act == 2) {
#pragma unroll
                        for (int i = 0; i < 4; ++i) { v0[i] = fast_sigmoid(v0[i]); v1[i] = fast_sigmoid(v1[i]); } }
                    u32x4 w; w.x = cvt_pk_bf16(v0[0], v0[1]); w.y = cvt_pk_bf16(v0[2], v0[3]); w.z = cvt_pk_bf16(v1[0], v1[1]); w.w = cvt_pk_bf16(v1[2], v1[3]);
                    *(u32x4*)(rowp + bj * HALF) = w; } }
    }
};
struct EpiGate {
    static constexpr bool PERM = true, AFTER_DRAIN = false;
    bf16_t* O; int ldo; const bf16_t* gate; int ldg; const bf16_t* add; int lda;
    __device__ __forceinline__ void operator()(const f32x4 (&acc)[2][2][4][2], const Unit& u, int wr, int wc, int fr, int fq) const {
        const int row0 = u.pm * BM + wr * 64 + fr, col0 = u.pn * BM + wc * 32 + 8 * fq;
#pragma unroll
        for (int ai = 0; ai < 2; ++ai)
#pragma unroll
            for (int m = 0; m < 4; ++m) { const size_t row = (size_t)(row0 + ai * HALF + m * 16);
#pragma unroll
                for (int bj = 0; bj < 2; ++bj) { const int col = col0 + bj * HALF;
                    const u32x4 gw = *(const u32x4*)(gate + row * ldg + col);
                    f32x4 v0 = acc[ai][bj][m][0], v1 = acc[ai][bj][m][1];
                    v0[0] *= bflo(gw.x); v0[1] *= bfhi(gw.x); v0[2] *= bflo(gw.y); v0[3] *= bfhi(gw.y);
                    v1[0] *= bflo(gw.z); v1[1] *= bfhi(gw.z); v1[2] *= bflo(gw.w); v1[3] *= bfhi(gw.w);
                    if (add) { const u32x4 aw = *(const u32x4*)(add + row * lda + col);
                        v0[0] += bflo(aw.x); v0[1] += bfhi(aw.x); v0[2] += bflo(aw.y); v0[3] += bfhi(aw.y);
                        v1[0] += bflo(aw.z); v1[1] += bfhi(aw.z); v1[2] += bflo(aw.w); v1[3] += bfhi(aw.w); }
                    u32x4 w; w.x = cvt_pk_bf16(v0[0], v0[1]); w.y = cvt_pk_bf16(v0[2], v0[3]); w.z = cvt_pk_bf16(v1[0], v1[1]); w.w = cvt_pk_bf16(v1[2], v1[3]);
                    *(u32x4*)(O + row * ldo + col) = w; } }
    }
};
struct EpiRes {
    static constexpr bool PERM = false, AFTER_DRAIN = false;
    const float* res; float* out; const float* gvec;
    __device__ __forceinline__ void operator()(const f32x4 (&acc)[2][2][4][2], const Unit& u, int wr, int wc, int fr, int fq) const {
        const int row0 = u.pm * BM + wr * 64 + fr, col0 = u.pn * BM + wc * 32 + 4 * fq;
        const float* gv = gvec + (u.pm >> 5) * 6144;
        f32x4 g4[2][2];
#pragma unroll
        for (int bj = 0; bj < 2; ++bj)
#pragma unroll
            for (int n = 0; n < 2; ++n) g4[bj][n] = *(const f32x4*)(gv + col0 + bj * HALF + n * 16);
#pragma unroll
        for (int ai = 0; ai < 2; ++ai)
#pragma unroll
            for (int m = 0; m < 4; ++m) { const size_t off = (size_t)(row0 + ai * HALF + m * 16) * 1024 + col0;
#pragma unroll
                for (int bj = 0; bj < 2; ++bj)
#pragma unroll
                    for (int n = 0; n < 2; ++n) { const f32x4 r = *(const f32x4*)(res + off + bj * HALF + n * 16);
                        *(f32x4*)(out + off + bj * HALF + n * 16) = r + g4[bj][n] * acc[ai][bj][m][n]; } }
    }
};
struct EpiSwiGLU {
    static constexpr bool PERM = true, AFTER_DRAIN = false;
    bf16_t* O; int ldo;
    __device__ __forceinline__ void operator()(const f32x4 (&acc)[2][2][4][2], const Unit& u, int wr, int wc, int fr, int fq) const {
        const int row0 = u.pm * BM + wr * 64 + fr, col0 = u.pn * HALF + wc * 32 + 8 * fq;
#pragma unroll
        for (int ai = 0; ai < 2; ++ai)
#pragma unroll
            for (int m = 0; m < 4; ++m) { bf16_t* rowp = O + (size_t)(row0 + ai * HALF + m * 16) * ldo + col0;
                f32x4 v[2];
#pragma unroll
                for (int n = 0; n < 2; ++n) { const f32x4 gt = acc[ai][0][m][n], up = acc[ai][1][m][n];
#pragma unroll
                    for (int i = 0; i < 4; ++i) v[n][i] = gt[i] * fast_sigmoid(gt[i]) * up[i]; }
                u32x4 w; w.x = cvt_pk_bf16(v[0][0], v[0][1]); w.y = cvt_pk_bf16(v[0][2], v[0][3]); w.z = cvt_pk_bf16(v[1][0], v[1][1]); w.w = cvt_pk_bf16(v[1][2], v[1][3]);
                *(u32x4*)rowp = w; }
    }
};
template <class Epi, class Sched, bool ALIGN_EPI = false, bool SP2 = false>
__device__ __forceinline__ void gemm_phase(PG8_LAS unsigned char* lds, const Gemm g, const Sched& S, const Epi& E) {
    const int tid = threadIdx.x, wid = __builtin_amdgcn_readfirstlane(tid >> 6), lane = tid & 63, wr = wid >> 2, wc = wid & 3, fr = lane & 15, fq = lane >> 4;
    const int K = g.K, nt = K / BK;
    unsigned voffA[2], voffB[2];
#pragma unroll
    for (int i = 0; i < 2; ++i) { int R, C; stage_rc(tid * 16 + i * 8192, R, C); const int Rb = Epi::PERM ? ((R & ~31) + perm32(R & 31)) : R;
        voffA[i] = (unsigned)(R * K + C) * 2u; voffB[i] = (unsigned)(Rb * K + C) * 2u; }
    const size_t kstep = (size_t)(BK * 2);
    const size_t hstep = (size_t)HALF * K * 2;
    const size_t tstep = 2 * hstep;
    const unsigned ldsw = (unsigned)wid * 1024u;
    const int aoff = lds_byte(wr * 64 + fr, fq * 8), boff = lds_byte(wc * 32 + fr, fq * 8);
#define PG8_SA(b, h) (((b) * 2 + (h)) * HTB)
#define PG8_SB(b, h) ((4 + (b) * 2 + (h)) * HTB)
#define PG8_STAGE(bufoff, gbase, voff) do { _Pragma("unroll") for (int _i = 0; _i < 2; ++_i) \
        __builtin_amdgcn_global_load_lds((const unsigned*)((const char*)(gbase) + (voff)[_i]), (PG8_LAS unsigned*)(lds + (bufoff) + ldsw + _i * 8192), 16, 0, 0); } while (0)
#define PG8_LDA(dst, b, h) do { _Pragma("unroll") for (int m = 0; m < 4; ++m) _Pragma("unroll") for (int k = 0; k < 2; ++k) dst[m][k] = *(const PG8_LAS bf16x8*)(lds + PG8_SA(b, h) + aoff + m * 2048 + k * 1024); } while (0)
#define PG8_LDB(dst, b, h) do { _Pragma("unroll") for (int n = 0; n < 2; ++n) _Pragma("unroll") for (int k = 0; k < 2; ++k) dst[n][k] = *(const PG8_LAS bf16x8*)(lds + PG8_SB(b, h) + boff + n * 2048 + k * 1024); } while (0)
#define PG8_MMA(ai, bj, At, Bt) do { __builtin_amdgcn_s_setprio(1); _Pragma("unroll") for (int m = 0; m < 4; ++m) _Pragma("unroll") for (int n = 0; n < 2; ++n) _Pragma("unroll") for (int k = 0; k < 2; ++k) \
        acc[ai][bj][m][n] = __builtin_amdgcn_mfma_f32_16x16x32_bf16(Bt[n][k], At[m][k], acc[ai][bj][m][n], 0, 0, 0); __builtin_amdgcn_s_setprio(0); } while (0)
#define PG8_WAIT_V(n) asm volatile("s_waitcnt vmcnt(" #n ")" ::: "memory")
#define PG8_WAIT_L(n) asm volatile("s_waitcnt lgkmcnt(" #n ")" ::: "memory")
#define PG8_BAR __builtin_amdgcn_s_barrier()
#define PG8_SCHED __builtin_amdgcn_sched_barrier(0)
    Unit cur, nxt; int ui = 0;
    if (!S.next(0, cur)) return;
    f32x4 acc[2][2][4][2];
#pragma unroll
    for (int a = 0; a < 2; ++a)
#pragma unroll
        for (int b = 0; b < 2; ++b)
#pragma unroll
            for (int m = 0; m < 4; ++m)
#pragma unroll
                for (int n = 0; n < 2; ++n) acc[a][b][m][n] = (f32x4){0.f, 0.f, 0.f, 0.f};
    bf16x8 At[4][2], B0[2][2], B1[2][2];
    const char* cA = (const char*)g.A + (size_t)cur.pm * tstep; const char* cB = (const char*)g.Bt + (size_t)cur.pn * tstep;
    S.a_ready(cur);
    if constexpr (SP2) {
        PG8_STAGE(PG8_SB(0, 0), cB, voffB); PG8_STAGE(PG8_SB(0, 1), cB + hstep, voffB); PG8_STAGE(PG8_SA(0, 0), cA, voffA); PG8_STAGE(PG8_SA(0, 1), cA + hstep, voffA);
        if (wr == 1) PG8_BAR;
        PG8_WAIT_V(2); PG8_BAR;
        PG8_STAGE(PG8_SB(1, 0), cB + kstep, voffB); PG8_STAGE(PG8_SA(1, 0), cA + kstep, voffA); PG8_STAGE(PG8_SB(1, 1), cB + hstep + kstep, voffB);
        PG8_WAIT_V(6); PG8_BAR;
    } else {
        PG8_STAGE(PG8_SB(0, 0), cB, voffB); PG8_STAGE(PG8_SA(0, 0), cA, voffA); PG8_STAGE(PG8_SB(0, 1), cB + hstep, voffB); PG8_STAGE(PG8_SA(0, 1), cA + hstep, voffA);
        if (wr == 1) PG8_BAR;
        PG8_WAIT_V(4); PG8_BAR;
        PG8_STAGE(PG8_SB(1, 0), cB + kstep, voffB); PG8_STAGE(PG8_SA(1, 0), cA + kstep, voffA); PG8_STAGE(PG8_SB(1, 1), cB + hstep + kstep, voffB);
        PG8_WAIT_V(6); PG8_BAR;
    }
    for (;;) {
        const bool has_next = S.next(ui + 1, nxt);
        const char* nA = has_next ? (const char*)g.A + (size_t)nxt.pm * tstep : cA; const char* nB = has_next ? (const char*)g.Bt + (size_t)nxt.pn * tstep : cB;
        for (int t = 0; t < nt; t += 2) {
            const bool last = (t == nt - 2);
            const char* a1 = cA + (size_t)(t + 1) * kstep;
            const char* a2 = last ? nA : cA + (size_t)(t + 2) * kstep; const char* b2 = last ? nB : cB + (size_t)(t + 2) * kstep;
            const char* a3 = a2 + kstep; const char* b3 = b2 + kstep;
            if (last && has_next) S.a_ready(nxt);
            if constexpr (SP2) {
            PG8_LDB(B0, 0, 0); PG8_LDB(B1, 0, 1); PG8_SCHED; PG8_LDA(At, 0, 0); PG8_STAGE(PG8_SA(1, 1), a1 + hstep, voffA);
            PG8_WAIT_V(8); PG8_WAIT_L(0); PG8_BAR; PG8_MMA(0, 0, At, B0); PG8_MMA(0, 1, At, B1); PG8_BAR; PG8_SCHED;
            PG8_LDA(At, 0, 1); PG8_STAGE(PG8_SB(0, 0), b2, voffB); PG8_STAGE(PG8_SB(0, 1), b2 + hstep, voffB); PG8_STAGE(PG8_SA(0, 0), a2, voffA);
            PG8_WAIT_V(8); PG8_WAIT_L(0); PG8_BAR; PG8_MMA(1, 0, At, B0); PG8_MMA(1, 1, At, B1); PG8_BAR; PG8_SCHED;
            PG8_LDB(B0, 1, 0); PG8_LDB(B1, 1, 1); PG8_SCHED; PG8_LDA(At, 1, 0); PG8_STAGE(PG8_SA(0, 1), a2 + hstep, voffA);
            PG8_WAIT_V(8); PG8_WAIT_L(0); PG8_BAR; PG8_MMA(0, 0, At, B0); PG8_MMA(0, 1, At, B1); PG8_BAR; PG8_SCHED;
            PG8_LDA(At, 1, 1); PG8_STAGE(PG8_SB(1, 0), b3, voffB); PG8_STAGE(PG8_SB(1, 1), b3 + hstep, voffB); PG8_STAGE(PG8_SA(1, 0), a3, voffA);
            PG8_WAIT_V(8); PG8_WAIT_L(0); PG8_BAR; PG8_MMA(1, 0, At, B0); PG8_MMA(1, 1, At, B1); PG8_BAR; PG8_SCHED;
            } else {
            PG8_LDB(B0, 0, 0); PG8_SCHED; PG8_LDA(At, 0, 0); PG8_STAGE(PG8_SA(1, 1), a1 + hstep, voffA);
            PG8_WAIT_L(8); PG8_BAR; PG8_WAIT_L(0); PG8_MMA(0, 0, At, B0); PG8_BAR; PG8_SCHED;
            PG8_LDB(B1, 0, 1); PG8_STAGE(PG8_SB(0, 0), b2, voffB);
            PG8_BAR; PG8_WAIT_L(0); PG8_MMA(0, 1, At, B1); PG8_BAR;
            PG8_LDA(At, 0, 1); PG8_STAGE(PG8_SA(0, 0), a2, voffA);
            PG8_BAR; PG8_WAIT_L(0); PG8_MMA(1, 0, At, B0); PG8_BAR; PG8_SCHED;
            PG8_STAGE(PG8_SB(0, 1), b2 + hstep, voffB);
            PG8_WAIT_V(6); PG8_BAR; PG8_MMA(1, 1, At, B1); PG8_BAR;
            PG8_LDB(B0, 1, 0); PG8_SCHED; PG8_LDA(At, 1, 0); PG8_STAGE(PG8_SA(0, 1), a2 + hstep, voffA);
            PG8_WAIT_L(8); PG8_BAR; PG8_WAIT_L(0); PG8_MMA(0, 0, At, B0); PG8_BAR; PG8_SCHED;
            PG8_LDB(B1, 1, 1); PG8_STAGE(PG8_SB(1, 0), b3, voffB);
            PG8_BAR; PG8_WAIT_L(0); PG8_MMA(0, 1, At, B1); PG8_BAR;
            PG8_LDA(At, 1, 1); PG8_STAGE(PG8_SA(1, 0), a3, voffA);
            PG8_BAR; PG8_WAIT_L(0); PG8_MMA(1, 0, At, B0); PG8_BAR; PG8_SCHED;
            PG8_STAGE(PG8_SB(1, 1), b3 + hstep, voffB);
            PG8_WAIT_V(6); PG8_BAR; PG8_MMA(1, 1, At, B1); PG8_BAR;
            }
        }
        if constexpr (ALIGN_EPI) { if (wr == 0) PG8_BAR; }
        if constexpr (!Epi::AFTER_DRAIN) { E(acc, cur, wr, wc, fr, fq); S.done(cur); }
        if (!has_next) break;
#pragma unroll
        for (int a = 0; a < 2; ++a)
#pragma unroll
            for (int b = 0; b < 2; ++b)
#pragma unroll
                for (int m = 0; m < 4; ++m)
#pragma unroll
                    for (int n = 0; n < 2; ++n) acc[a][b][m][n] = (f32x4){0.f, 0.f, 0.f, 0.f};
        cur = nxt; cA = nA; cB = nB; ++ui;
        if constexpr (ALIGN_EPI) { if (wr == 1) PG8_BAR; }
    }
    PG8_WAIT_V(0);
    if constexpr (!ALIGN_EPI) { if (wr == 0) PG8_BAR; }
    PG8_BAR;
    if constexpr (Epi::AFTER_DRAIN) { E.fused(acc, cur, wr, wc, fr, fq, lds, wid, lane); S.done(cur); }
#undef PG8_SA
#undef PG8_SB
#undef PG8_STAGE
#undef PG8_LDA
#undef PG8_LDB
#undef PG8_MMA
#undef PG8_WAIT_V
#undef PG8_WAIT_L
#undef PG8_BAR
#undef PG8_SCHED
}
}
constexpr int NWAVES = 8;
constexpr int BATCH = 2, SEQ = 8192, D = 1024, M = BATCH * SEQ;
constexpr int RW = 512, NH = 8, HD = 64;
constexpr int FF = 2816;
constexpr int IN_COLS = 4896, IN_PAD = 5120;
constexpr size_t MiB = 1u << 20;
constexpr size_t WS_CTL = 0, CTL_ZERO_BYTES = 1 * MiB, WS_MOD = 1 * MiB;
constexpr size_t WS_WIN = 2 * MiB, WS_WFFI = 12 * MiB, WS_WFFO = 23 * MiB, WS_WOUT = 29 * MiB, WS_WA = 31 * MiB, WS_WB = 32 * MiB;
constexpr size_t WS_H = 34 * MiB, WS_PRKV = 66 * MiB, WS_PLORA = 114 * MiB, WS_PUV = 130 * MiB, WS_SG = 162 * MiB, WS_TAIL = 226 * MiB, WS_END = 256 * MiB;
constexpr size_t WS_YB = 34 * MiB, WS_KK = 50 * MiB, WS_A = 226 * MiB, WS_Y = 130 * MiB, WS_YA = 114 * MiB, WS_M1 = 66 * MiB, WS_MERGED = 130 * MiB, WS_H2 = 34 * MiB, WS_ACT = 66 * MiB;
constexpr size_t OUT_LW = 0, OUT_G = 32 * MiB, OUT_BON = 48 * MiB;
constexpr int CW_TMO = 0, CW_CODE = 1, CW_BAR = 4096;
constexpr int RING_OFF = 0, RING_BYTES = 131072, LDSCTL_OFF = RING_BYTES, MISC_OFF = LDSCTL_OFF + 320, LDS_BYTES = 147456;

#define GAS __attribute__((address_space(1)))
#define LAS __attribute__((address_space(3)))
typedef unsigned short bf16;
typedef unsigned v4u __attribute__((ext_vector_type(4)));
typedef unsigned v2u __attribute__((ext_vector_type(2)));
typedef float f32x4 __attribute__((ext_vector_type(4)));
typedef GAS unsigned gu32;
#define RLX_AGENT __ATOMIC_RELAXED, __HIP_MEMORY_SCOPE_AGENT
#define LDS_WAIT() asm volatile("s_waitcnt lgkmcnt(0)" ::: "memory")
__device__ __forceinline__ unsigned f2bf(float f) { unsigned u = __builtin_bit_cast(unsigned, f); return (u + 0x7fffu + ((u >> 16) & 1u)) >> 16; }
__device__ __forceinline__ unsigned pk2(float lo, float hi) { return f2bf(lo) | (f2bf(hi) << 16); }
__device__ __forceinline__ float bf2f(bf16 v) { return __uint_as_float(((unsigned)v) << 16); }
__device__ __forceinline__ float bflo(unsigned w) { return __uint_as_float(w << 16); }
__device__ __forceinline__ float bfhi(unsigned w) { return __uint_as_float(w & 0xffff0000u); }
__device__ __forceinline__ float sigmoidf_(float x) { return 1.f / (1.f + __expf(-x)); }
__device__ __forceinline__ float softplusf_(float x) { return x > 20.f ? x : log1pf(expf(x)); }
__device__ __forceinline__ float wave_sum(float v) {
#pragma unroll
    for (int o = 1; o < 64; o <<= 1) v += __shfl_xor(v, o);
    return v;
}
#define XB_TMO      128
#define XB_XCNT(j)  (256  + 64 * (j))
#define XB_XSUB(j)  (1280 + 64 * (j))
#define XB_XGEN(j)  (2304 + 64 * (j))
#define XB_TOP      3328
#define XB_TOPGEN   3392
#define XCD_BAR_WORDS 3456
#define XB_SPIN_CAP (1u << 18)

__device__ __forceinline__ unsigned xb_ld(unsigned* p)              { return __hip_atomic_load(p, __ATOMIC_RELAXED, __HIP_MEMORY_SCOPE_AGENT); }
__device__ __forceinline__ unsigned xb_add(unsigned* p, unsigned v) { return __hip_atomic_fetch_add(p, v, __ATOMIC_RELAXED, __HIP_MEMORY_SCOPE_AGENT); }
__device__ __forceinline__ unsigned xb_xcc_id() { return (unsigned)__builtin_amdgcn_s_getreg((3 << 11) | 20) & 0xFu; }
#define XB_SPIN(cond, bar) do { unsigned _sp = 0; while (cond) { __builtin_amdgcn_s_sleep(1); \
    if ((++_sp & 255u) == 0u) { if (xb_ld(&(bar)[XB_TMO])) break; if (_sp > XB_SPIN_CAP) { atomicAdd(&(bar)[XB_TMO], 1u); break; } } } } while (0)

struct XcdBarrier {
    unsigned* bar; unsigned x;
    volatile LAS unsigned* st;
};

__device__ __forceinline__ XcdBarrier xcd_barrier_post(unsigned* bar, volatile LAS unsigned* st) {
    XcdBarrier b; b.bar = bar; b.x = xb_xcc_id(); b.st = st;
    if (threadIdx.x == 0) (void)xb_add(&bar[XB_XCNT(b.x)], 1u);
    return b;
}
__device__ __forceinline__ void xcd_barrier_complete(unsigned* bar, unsigned x, unsigned& nloc, unsigned& nx) {
    const unsigned G = gridDim.x * gridDim.y * gridDim.z;
    unsigned sum, cnt, mine, sp = 0u;
    for (;;) {
        sum = 0u; cnt = 0u; mine = 0u;
#pragma unroll
        for (unsigned j = 0; j < 16; ++j) { const unsigned c = xb_ld(&bar[XB_XCNT(j)]); sum += c; cnt += (c > 0u) ? 1u : 0u; mine = (j == x) ? c : mine; }
        if (sum == G) break;
        __builtin_amdgcn_s_sleep(1);
        if ((++sp & 255u) == 0u) { if (xb_ld(&bar[XB_TMO])) break; if (sp > XB_SPIN_CAP) { atomicAdd(&bar[XB_TMO], 1u); break; } }
    }
    nloc = mine > 0u ? mine : 1u; nx = cnt > 0u ? cnt : 1u;
}

__device__ __forceinline__ void xcd_barrier(const XcdBarrier& b) {
    asm volatile("s_waitcnt vmcnt(0)" ::: "memory");
    __syncthreads();
    if (threadIdx.x == 0) {
        unsigned* bar = b.bar;
        __builtin_amdgcn_s_waitcnt(0);
        unsigned nloc = b.st[0], nx = b.st[1];
        if (nloc == 0u) { xcd_barrier_complete(bar, b.x, nloc, nx); b.st[0] = nloc; b.st[1] = nx; }
        const unsigned old = xb_add(&bar[XB_XSUB(b.x)], 1u);
        const unsigned gen = old / nloc;
        if (old + 1u == (gen + 1u) * nloc) {
            __builtin_amdgcn_fence(__ATOMIC_RELEASE, "agent");
            asm volatile("s_waitcnt vmcnt(0)" ::: "memory");
            const unsigned og = xb_add(&bar[XB_TOP], 1u);
            const unsigned tg = og / nx;
            if (og + 1u == (tg + 1u) * nx) xb_add(&bar[XB_TOPGEN], 1u);
            else XB_SPIN(xb_ld(&bar[XB_TOPGEN]) == tg, bar);
            __builtin_amdgcn_fence(__ATOMIC_ACQUIRE, "agent");
            xb_add(&bar[XB_XGEN(b.x)], 1u);
            asm volatile("s_waitcnt vmcnt(0)" ::: "memory");
        } else {
            XB_SPIN(xb_ld(&bar[XB_XGEN(b.x)]) == gen, bar);
            __builtin_amdgcn_fence(__ATOMIC_ACQUIRE, "agent");
            asm volatile("s_waitcnt vmcnt(0)" ::: "memory");
        }
    }
    __syncthreads();
}
struct Args {
    const float *x, *c, *w_ada, *b_ada, *norm1_g, *norm2_g, *normf_g, *w_in, *mu, *w0, *wdu, *a0, *wau, *wgu, *k_k, *k_a, *r_k, *lnx_g, *lnx_b, *gln_g, *gln_b, *w_sp, *b_sp, *w_ba, *w_bb, *w_out, *w_fi, *w_fo;
    float* out; unsigned char* ws; int ph_lo, ph_hi;
};
struct Frame { LAS unsigned char* lds; volatile LAS unsigned* MISC; gu32* ctl; int tid, lane, wave, vcu, G; };

__device__ __forceinline__ void mod_item(const Args& a, float* mod, int item, int lane) {
    const int n0 = item * 16, kg = lane >> 2, cq = lane & 3;
    f32x4 acc0 = {0.f, 0.f, 0.f, 0.f}, acc1 = {0.f, 0.f, 0.f, 0.f};
#pragma unroll 8
    for (int i = 0; i < 64; ++i) { const int k = kg + 16 * i;
        const f32x4 w = *(const f32x4*)(a.w_ada + (size_t)k * (6 * D) + n0 + 4 * cq);
        const float c0 = a.c[k], c1 = a.c[D + k];
        const float s0 = c0 / (1.f + __expf(-c0)), s1 = c1 / (1.f + __expf(-c1));
        acc0 += s0 * w; acc1 += s1 * w; }
#pragma unroll
    for (int o = 4; o < 64; o <<= 1)
#pragma unroll
        for (int j = 0; j < 4; ++j) { acc0[j] += __shfl_xor(acc0[j], o); acc1[j] += __shfl_xor(acc1[j], o); }
    if (kg == 0) { const f32x4 b = *(const f32x4*)(a.b_ada + n0 + 4 * cq);
        *(f32x4*)(mod + n0 + 4 * cq) = acc0 + b; *(f32x4*)(mod + 6 * D + n0 + 4 * cq) = acc1 + b; }
}
__device__ __forceinline__ void transpose_item(const float* W, int ldw, int s0, int K, bf16* WT, int d0, int k0, LAS float* scr, int lane) {
    if (s0 >= 0) {
#pragma unroll 8
        for (int i = 0; i < 32; ++i) { const int kk = 2 * i + (lane >> 5); scr[kk * 33 + (lane & 31)] = W[(size_t)(k0 + kk) * ldw + s0 + (lane & 31)]; }
    } else {
#pragma unroll 8
        for (int i = 0; i < 32; ++i) { const int kk = 2 * i + (lane >> 5); scr[kk * 33 + (lane & 31)] = 0.f; }
    }
    LDS_WAIT(); asm volatile("" ::: "memory");
    const int c = lane & 7;
#pragma unroll
    for (int j = 0; j < 4; ++j) { const int n = (lane >> 3) + 8 * j; const LAS float* s = scr + (8 * c) * 33 + n;
        v4u o; o.x = pk2(s[0 * 33], s[1 * 33]); o.y = pk2(s[2 * 33], s[3 * 33]); o.z = pk2(s[4 * 33], s[5 * 33]); o.w = pk2(s[6 * 33], s[7 * 33]);
        *(GAS v4u*)(WT + (size_t)(d0 + n) * K + k0 + 8 * c) = o; }
    LDS_WAIT(); asm volatile("" ::: "memory");
}
__device__ __forceinline__ void p0_prologue(const Args& a, Frame& F) {
    LAS float* scr = (LAS float*)(F.lds + RING_OFF + F.wave * 16384);
    const int gw = F.vcu * NWAVES + F.wave, NGW = F.G * NWAVES;
    unsigned char* ws = a.ws;
    float* mod = (float*)(ws + WS_MOD);
    for (int it = gw; it < 6 * D / 16; it += NGW) mod_item(a, mod, it, F.lane);
    constexpr int I_IN = 16 * 160, I_FFI = 16 * 176, I_FFO = 44 * 32, I_OUT = 16 * 32, I_BR = 8 * 32;
    constexpr int NITEMS = I_IN + I_FFI + I_FFO + I_OUT + 2 * I_BR;
    for (int it = gw; it < NITEMS; it += NGW) {
        int r = it;
        if (r < I_IN) { const int kb = r / 160, rb = r % 160, d0 = 32 * rb; const int s0 = d0 < 1824 ? d0 : (d0 < 2048 ? -1 : d0 - 224);
            transpose_item(a.w_in, IN_COLS, s0, D, (bf16*)(ws + WS_WIN), d0, 64 * kb, scr, F.lane); continue; } r -= I_IN;
        if (r < I_FFI) { const int kb = r / 176, rb = r % 176, d0 = 32 * rb, pn = d0 >> 8, w = d0 & 255; const int s0 = w < 128 ? 128 * pn + w : FF + 128 * pn + (w - 128);
            transpose_item(a.w_fi, 2 * FF, s0, D, (bf16*)(ws + WS_WFFI), d0, 64 * kb, scr, F.lane); continue; } r -= I_FFI;
        if (r < I_FFO) { const int kb = r / 32, rb = r % 32; transpose_item(a.w_fo, D, 32 * rb, FF, (bf16*)(ws + WS_WFFO), 32 * rb, 64 * kb, scr, F.lane); continue; } r -= I_FFO;
        if (r < I_OUT) { const int kb = r / 32, rb = r % 32; transpose_item(a.w_out, D, 32 * rb, D, (bf16*)(ws + WS_WOUT), 32 * rb, 64 * kb, scr, F.lane); continue; } r -= I_OUT;
        if (r < I_BR) { const int kb = r / 32, rb = r % 32; transpose_item(a.w_ba, D, 32 * rb, RW, (bf16*)(ws + WS_WA), 32 * rb, 64 * kb, scr, F.lane); continue; } r -= I_BR;
        { const int kb = r / 32, rb = r % 32; transpose_item(a.w_bb, D, 32 * rb, RW, (bf16*)(ws + WS_WB), 32 * rb, 64 * kb, scr, F.lane); }
    }
}
__device__ __forceinline__ void rmsnorm_mod_rows(const float* x, const float* g, const float* mod, int sh_off, int sc_off, bf16* out, Frame& F) {
    const int gw = F.vcu * NWAVES + F.wave, NGW = F.G * NWAVES;
    for (int row = gw; row < M; row += NGW) {
        const f32x4* xr = (const f32x4*)(x + (size_t)row * D) + F.lane;
        f32x4 v[4]; float s = 0.f;
#pragma unroll
        for (int j = 0; j < 4; ++j) { v[j] = xr[64 * j]; s += (v[j].x * v[j].x + v[j].y * v[j].y) + (v[j].z * v[j].z + v[j].w * v[j].w); }
        const float rstd = 1.0f / sqrtf(wave_sum(s) * (1.f / D) + 1e-6f);
        const float* mb = mod + (row / SEQ) * 6 * D;
        unsigned long long* o8 = (unsigned long long*)(out + (size_t)row * D) + F.lane;
#pragma unroll
        for (int j = 0; j < 4; ++j) { const f32x4 gv = ((const f32x4*)g)[F.lane + 64 * j], sh = ((const f32x4*)(mb + sh_off))[F.lane + 64 * j], sc = ((const f32x4*)(mb + sc_off))[F.lane + 64 * j];
            const f32x4 y = v[j] * rstd * gv * (1.f + sc) + sh;
            o8[64 * j] = (unsigned long long)pk2(y.x, y.y) | ((unsigned long long)pk2(y.z, y.w) << 32); }
    }
}
__device__ __forceinline__ void rmsnorm_final_rows(float* x, const float* g, Frame& F) {
    const int gw = F.vcu * NWAVES + F.wave, NGW = F.G * NWAVES;
    for (int row = gw; row < M; row += NGW) {
        f32x4* xr = (f32x4*)(x + (size_t)row * D) + F.lane;
        f32x4 v[4]; float s = 0.f;
#pragma unroll
        for (int j = 0; j < 4; ++j) { v[j] = xr[64 * j]; s += (v[j].x * v[j].x + v[j].y * v[j].y) + (v[j].z * v[j].z + v[j].w * v[j].w); }
        const float rstd = 1.0f / sqrtf(wave_sum(s) * (1.f / D) + 1e-6f);
#pragma unroll
        for (int j = 0; j < 4; ++j) xr[64 * j] = v[j] * rstd * ((const f32x4*)g)[F.lane + 64 * j];
    }
}
__device__ __forceinline__ void gmlp_units(const Args& a, Frame& F) {
    const bf16* Puv = (const bf16*)(a.ws + WS_PUV); bf16* YB = (bf16*)(a.ws + WS_YB);
    LAS float* vn = (LAS float*)(F.lds + RING_OFF);
    LAS float* wsl = (LAS float*)(F.lds + RING_OFF + 65536);
    (void)wsl;
    LAS float* stat = (LAS float*)(F.lds + RING_OFF + 65536);
    for (int unit = F.vcu; unit < (M / 128) * 4; unit += F.G) {
        const int g = unit & 3, row0 = (unit >> 2) * 128;
        for (int r = F.wave; r < 128; r += NWAVES) {
            const v4u w = *(const v4u*)(Puv + (size_t)(row0 + r) * 1024 + 512 + 8 * F.lane);
            const float v[8] = {bflo(w.x), bfhi(w.x), bflo(w.y), bfhi(w.y), bflo(w.z), bfhi(w.z), bflo(w.w), bfhi(w.w)};
            float s = 0.f;
#pragma unroll
            for (int j = 0; j < 8; ++j) s += v[j];
            const float mean = wave_sum(s) * (1.f / 512.f); float q = 0.f;
#pragma unroll
            for (int j = 0; j < 8; ++j) { const float d = v[j] - mean; q += d * d; }
            const float var = wave_sum(q) * (1.f / 512.f);
            if (F.lane == 0) { stat[2 * r] = mean; stat[2 * r + 1] = 1.0f / sqrtf(var + 1e-5f); }
        }
        __syncthreads();
        for (int i = F.tid; i < 128 * 128; i += NWAVES * 64) { const int r = i >> 7, d = i & 127, ch = g * 128 + d;
            vn[i] = (bf2f(Puv[(size_t)(row0 + r) * 1024 + 512 + ch]) - stat[2 * r]) * stat[2 * r + 1] * a.gln_g[ch] + a.gln_b[ch]; }
        __syncthreads();
        const int d = F.tid & 127, rg = F.tid >> 7;
        for (int ii = 0; ii < 8; ++ii) {
            const int i0 = 4 * (rg + 4 * ii), jmax = i0 < 64 ? 64 : 128;
            const float* wr = a.w_sp + ((size_t)g * 128 + i0) * 128;
            float acc[4] = {0.f, 0.f, 0.f, 0.f};
            for (int j = 0; j < jmax; j += 4) {
                const float v0 = vn[(j + 0) * 128 + d], v1 = vn[(j + 1) * 128 + d], v2 = vn[(j + 2) * 128 + d], v3 = vn[(j + 3) * 128 + d];
#pragma unroll
                for (int q = 0; q < 4; ++q) { const f32x4 w = *(const f32x4*)(wr + q * 128 + j); acc[q] += (w.x * v0 + w.y * v1) + (w.z * v2 + w.w * v3); }
            }
#pragma unroll
            for (int q = 0; q < 4; ++q) { const int i = i0 + q; const float sv = acc[q] + a.b_sp[g * 128 + i];
                const float u = bf2f(Puv[(size_t)(row0 + i) * 1024 + g * 128 + d]);
                YB[(size_t)(row0 + i) * 512 + g * 128 + d] = (bf16)f2bf(u * sv); }
        }
        __syncthreads();
    }
}
__device__ __forceinline__ void prep_units(const Args& a, Frame& F) {
    const bf16* Prkv = (const bf16*)(a.ws + WS_PRKV); const bf16* Plora = (const bf16*)(a.ws + WS_PLORA);
    bf16* KK = (bf16*)(a.ws + WS_KK); bf16* A = (bf16*)(a.ws + WS_A); float* LW = (float*)((unsigned char*)a.out + OUT_LW);
    bf16* G = (bf16*)((unsigned char*)a.out + OUT_G); bf16* BON = (bf16*)((unsigned char*)a.out + OUT_BON);
    LAS float* lin = (LAS float*)(F.lds + RING_OFF);
    const int c = F.tid;
    for (int unit = F.vcu; unit < M / 16; unit += F.G) {
        const int t0 = unit * 16;
        for (int i = F.tid; i < 16 * 288; i += NWAVES * 64) {
            const int tt = i / 288, j = i % 288, t = t0 + tt;
            const float cur = bf2f(Plora[(size_t)t * 512 + j]);
            const float prev = (t % SEQ) == 0 ? 0.f : bf2f(Plora[(size_t)(t - 1) * 512 + j]);
            const float xs = cur + (prev - cur) * a.mu[1536 + j];
            lin[tt * 288 + j] = j < 64 ? tanhf(xs) : (j < 128 ? xs : sigmoidf_(xs));
        }
        __syncthreads();
        float dw[16], da[16], dg[16];
#pragma unroll
        for (int tt = 0; tt < 16; ++tt) { dw[tt] = 0.f; da[tt] = 0.f; dg[tt] = 0.f; }
        for (int j = 0; j < 64; ++j) { const float w = a.wdu[j * 512 + c];
#pragma unroll
            for (int tt = 0; tt < 16; ++tt) dw[tt] += lin[tt * 288 + j] * w; }
        for (int j = 0; j < 64; ++j) { const float w = a.wau[j * 512 + c];
#pragma unroll
            for (int tt = 0; tt < 16; ++tt) da[tt] += lin[tt * 288 + 64 + j] * w; }
        for (int j = 0; j < 160; ++j) { const float w = a.wgu[j * 512 + c];
#pragma unroll
            for (int tt = 0; tt < 16; ++tt) dg[tt] += lin[tt * 288 + 128 + j] * w; }
        const float mur = a.mu[c], muk = a.mu[512 + c], muv = a.mu[1024 + c], w0c = a.w0[c], a0c = a.a0[c], kkc = a.k_k[c], kac = a.k_a[c], rkc = a.r_k[c];
        float pr, pk, pv;
        if ((t0 % SEQ) == 0) { pr = 0.f; pk = 0.f; pv = 0.f; }
        else { pr = bf2f(Prkv[(size_t)(t0 - 1) * 1536 + c]); pk = bf2f(Prkv[(size_t)(t0 - 1) * 1536 + 512 + c]); pv = bf2f(Prkv[(size_t)(t0 - 1) * 1536 + 1024 + c]); }
#pragma unroll
        for (int tt = 0; tt < 16; ++tt) {
            const int t = t0 + tt;
            const float cr = bf2f(Prkv[(size_t)t * 1536 + c]), ck = bf2f(Prkv[(size_t)t * 1536 + 512 + c]), cv = bf2f(Prkv[(size_t)t * 1536 + 1024 + c]);
            const float r = cr + (pr - cr) * mur, k = ck + (pk - ck) * muk, v = cv + (pv - cv) * muv;
            pr = cr; pk = ck; pv = cv;
            const float wlog = -softplusf_(-(w0c + dw[tt])) - 0.5f;
            const float lw = -expf(wlog);
            const float av = sigmoidf_(a0c + da[tt]);
            float kk = k * kkc;
            const float nrm = sqrtf(wave_sum(kk * kk));
            kk = kk / fmaxf(nrm, 1e-12f);
            const float k2 = k * (1.f + (av - 1.f) * kac);
            const float bon = wave_sum(r * k2 * rkc) * v;
            const size_t o = (size_t)t * 512 + c;
            KK[o] = (bf16)f2bf(kk); A[o] = (bf16)f2bf(av); LW[o] = lw; G[o] = (bf16)f2bf(dg[tt]); BON[o] = (bf16)f2bf(bon);
        }
        __syncthreads();
    }
}
__device__ __forceinline__ void scan_naive(const Args& a, Frame& F) {
    const int gwv = (int)blockIdx.x * NWAVES + F.wave;
    if (gwv >= BATCH * NH * HD) return;
    const bf16* Prkv = (const bf16*)(a.ws + WS_PRKV); const bf16* KK = (const bf16*)(a.ws + WS_KK); const bf16* A = (const bf16*)(a.ws + WS_A);
    const float* LW = (const float*)((unsigned char*)a.out + OUT_LW); float* Y = (float*)(a.ws + WS_Y);
    const int vrow = gwv & 63, h = (gwv >> 6) & 7, b = gwv >> 9, lane = F.lane;
    const int ch = h * 64 + lane, chv = h * 64 + vrow;
    const float mur = a.mu[ch], muk = a.mu[512 + ch], muv = a.mu[1024 + chv], kac = a.k_a[ch];
    float S = 0.f, pr = 0.f, pk = 0.f, pv = 0.f;
    const size_t tb = (size_t)b * SEQ;
    for (int t0 = 0; t0 < SEQ; t0 += 8) {
        float r[8], k[8], kk[8], av[8], w[8], vv[8];
#pragma unroll
        for (int i = 0; i < 8; ++i) { const size_t t = tb + t0 + i;
            r[i] = bf2f(Prkv[t * 1536 + ch]); k[i] = bf2f(Prkv[t * 1536 + 512 + ch]); vv[i] = bf2f(Prkv[t * 1536 + 1024 + chv]);
            kk[i] = bf2f(KK[t * 512 + ch]); av[i] = bf2f(A[t * 512 + ch]); w[i] = expf(LW[t * 512 + ch]); }
#pragma unroll
        for (int i = 0; i < 8; ++i) {
            const float rr = r[i] + (pr - r[i]) * mur, kx = k[i] + (pk - k[i]) * muk, vx = vv[i] + (pv - vv[i]) * muv;
            pr = r[i]; pk = k[i]; pv = vv[i];
            const float k2 = kx * (1.f + (av[i] - 1.f) * kac);
            const float sa = wave_sum(S * (-kk[i]));
            S = S * w[i] + sa * (kk[i] * av[i]) + vx * k2;
            const float y = wave_sum(S * rr);
            if (lane == 0) Y[(tb + t0 + i) * 512 + chv] = y;
        }
    }
}
__device__ __forceinline__ void fin_units(const Args& a, Frame& F) {
    const float* Y = (const float*)(a.ws + WS_Y); const bf16* G = (const bf16*)((unsigned char*)a.out + OUT_G); const bf16* BON = (const bf16*)((unsigned char*)a.out + OUT_BON);
    bf16* YA = (bf16*)(a.ws + WS_YA);
    const int gw = F.vcu * NWAVES + F.wave, NGW = F.G * NWAVES;
    for (int it = gw; it < M * NH; it += NGW) {
        const int t = it >> 3, h = it & 7, c = h * 64 + F.lane; const size_t o = (size_t)t * 512 + c;
        const float y = Y[o];
        const float mean = wave_sum(y) * (1.f / 64.f); const float d = y - mean;
        const float var = wave_sum(d * d) * (1.f / 64.f);
        const float yn = d * (1.0f / sqrtf(var + 64e-5f)) * a.lnx_g[c] + a.lnx_b[c];
        YA[o] = (bf16)f2bf((yn + bf2f(BON[o])) * bf2f(G[o]));
    }
}

__global__ void __launch_bounds__(NWAVES * 64, 2) mega_fwd(Args args) {
    extern __shared__ __attribute__((aligned(16))) unsigned char lds[];
    Frame F;
    F.lds = (LAS unsigned char*)lds;
    F.MISC = (volatile LAS unsigned*)(F.lds + MISC_OFF);
    F.tid = threadIdx.x; F.lane = F.tid & 63; F.wave = __builtin_amdgcn_readfirstlane(F.tid >> 6);
    F.G = gridDim.x; { const int bx = blockIdx.x; F.vcu = (F.G % 8 == 0) ? (bx % 8) * (F.G / 8) + bx / 8 : bx; }
    unsigned char* ws = args.ws;
    F.ctl = (gu32*)(ws + WS_CTL);
    for (int u = F.tid; u < (LDS_BYTES - LDSCTL_OFF) / 4; u += NWAVES * 64) ((LAS unsigned*)(F.lds + LDSCTL_OFF))[u] = 0u;
    __syncthreads();
    const bool one_launch = (args.ph_hi - args.ph_lo) > 1;
    XcdBarrier bar; bar.bar = (unsigned*)(F.ctl + CW_BAR); bar.x = 0; bar.st = nullptr;
    if (one_launch) bar = xcd_barrier_post((unsigned*)(F.ctl + CW_BAR), F.MISC + 8);
    const int lo = args.ph_lo, hi = args.ph_hi;
#define IN(k) (lo <= (k) && (k) < hi)
#define SEAM(k) do { if (IN(k) && IN((k) + 1)) xcd_barrier(bar); } while (0)
    float* mod = (float*)(ws + WS_MOD);
    bf16* H = (bf16*)(ws + WS_H);
    if (IN(0)) { p0_prologue(args, F); } SEAM(0);
    if (IN(1)) { rmsnorm_mod_rows(args.x, args.norm1_g, mod, 0, D, H, F); } SEAM(1);
    if (IN(2)) { pg8::Gemm g{H, (const bf16*)(ws + WS_WIN), M, IN_PAD, D}; pg8::StaticOrder S; S.init(M, IN_PAD, F.G, (int)blockIdx.x);
        pg8::EpiIn E{(bf16*)(ws + WS_PRKV), (bf16*)(ws + WS_PLORA), (bf16*)(ws + WS_PUV), (bf16*)(ws + WS_SG)};
        pg8::gemm_phase<pg8::EpiIn, pg8::StaticOrder, true, true>(F.lds + RING_OFF, g, S, E); } SEAM(2);
    if (IN(3)) { gmlp_units(args, F); prep_units(args, F); } SEAM(3);
    if (IN(4)) { scan_naive(args, F); } SEAM(4);
    if (IN(5)) { fin_units(args, F);
        pg8::Gemm g{(const bf16*)(ws + WS_YB), (const bf16*)(ws + WS_WB), M, D, RW}; pg8::StaticOrder S; S.init(M, D, F.G, (int)blockIdx.x);
        pg8::EpiGate E{(bf16*)(ws + WS_M1), D, (const bf16*)(ws + WS_SG) + 1024, 2048, nullptr, 0};
        pg8::gemm_phase<pg8::EpiGate, pg8::StaticOrder, true, true>(F.lds + RING_OFF, g, S, E); } SEAM(5);
    if (IN(6)) { pg8::Gemm g{(const bf16*)(ws + WS_YA), (const bf16*)(ws + WS_WA), M, D, RW}; pg8::StaticOrder S; S.init(M, D, F.G, (int)blockIdx.x);
        pg8::EpiGate E{(bf16*)(ws + WS_MERGED), D, (const bf16*)(ws + WS_SG), 2048, (const bf16*)(ws + WS_M1), D};
        pg8::gemm_phase<pg8::EpiGate, pg8::StaticOrder, true, true>(F.lds + RING_OFF, g, S, E); } SEAM(6);
    if (IN(7)) { pg8::Gemm g{(const bf16*)(ws + WS_MERGED), (const bf16*)(ws + WS_WOUT), M, D, D}; pg8::StaticOrder S; S.init(M, D, F.G, (int)blockIdx.x);
        pg8::EpiRes E{args.x, args.out, mod + 2 * D};
        pg8::gemm_phase<pg8::EpiRes, pg8::StaticOrder, true, true>(F.lds + RING_OFF, g, S, E); } SEAM(7);
    if (IN(8)) { rmsnorm_mod_rows(args.out, args.norm2_g, mod, 3 * D, 4 * D, (bf16*)(ws + WS_H2), F); } SEAM(8);
    if (IN(9)) { pg8::Gemm g{(const bf16*)(ws + WS_H2), (const bf16*)(ws + WS_WFFI), M, 2 * FF, D}; pg8::StaticOrder S; S.init(M, 2 * FF, F.G, (int)blockIdx.x);
        pg8::EpiSwiGLU E{(bf16*)(ws + WS_ACT), FF};
        pg8::gemm_phase<pg8::EpiSwiGLU, pg8::StaticOrder, true, true>(F.lds + RING_OFF, g, S, E); } SEAM(9);
    if (IN(10)) { pg8::Gemm g{(const bf16*)(ws + WS_ACT), (const bf16*)(ws + WS_WFFO), M, D, FF}; pg8::StaticOrder S; S.init(M, D, F.G, (int)blockIdx.x);
        pg8::EpiRes E{args.out, args.out, mod + 5 * D};
        pg8::gemm_phase<pg8::EpiRes, pg8::StaticOrder, true, true>(F.lds + RING_OFF, g, S, E); } SEAM(10);
    if (IN(11)) { rmsnorm_final_rows(args.out, args.normf_g, F); }
#undef IN
#undef SEAM
}

#ifndef MK_ONE_LAUNCH
#define MK_ONE_LAUNCH 1
#endif
extern "C" void kernel_launch(void* const* d_in, const int* in_sizes, int n_in, void* d_out, int out_size, void* d_ws, size_t ws_size, hipStream_t stream) {
    static int grid = 0;
    if (grid == 0) {
        if (n_in != 28 || out_size != M * D || ws_size < WS_END) { fprintf(stderr, "kernel_launch: unexpected shapes (n_in %d out %d ws %zu)\n", n_in, out_size, ws_size); grid = -1; return; }
        int dev = 0, cus = 0, per_cu = 0;
        if (hipGetDevice(&dev) != hipSuccess || hipDeviceGetAttribute(&cus, hipDeviceAttributeMultiprocessorCount, dev) != hipSuccess) { grid = -1; return; }
        if (hipFuncSetAttribute((const void*)mega_fwd, hipFuncAttributeMaxDynamicSharedMemorySize, LDS_BYTES) != hipSuccess) { fprintf(stderr, "kernel_launch: hipFuncSetAttribute failed\n"); grid = -1; return; }
        if (hipOccupancyMaxActiveBlocksPerMultiprocessor(&per_cu, (const void*)mega_fwd, NWAVES * 64, LDS_BYTES) != hipSuccess || per_cu < 1) { fprintf(stderr, "kernel_launch: occupancy query says %d\n", per_cu); per_cu = 1; }
        (void)hipGetLastError();
        grid = cus;
    }
    if (grid < 0) return;
    (void)hipMemsetAsync((char*)d_ws + WS_CTL, 0, CTL_ZERO_BYTES, stream);
    Args a{};
    const float** ap = (const float**)&a;
    for (int i = 0; i < 28; ++i) ap[i] = (const float*)d_in[i];
    a.out = (float*)d_out; a.ws = (unsigned char*)d_ws;
#if MK_ONE_LAUNCH
    a.ph_lo = 0; a.ph_hi = 12;
    hipLaunchKernelGGL(mega_fwd, dim3(grid), dim3(NWAVES * 64), LDS_BYTES, stream, a);
#else
    for (int p = 0; p < 12; ++p) { a.ph_lo = p; a.ph_hi = p + 1; hipLaunchKernelGGL(mega_fwd, dim3(grid), dim3(NWAVES * 64), LDS_BYTES, stream, a); }
#endif
}
```

```cpp
#include <hip/hip_runtime.h>
#include <cstdio>
#include <cstdint>
namespace pg8 {
#define PG8_LAS __attribute__((address_space(3)))
typedef unsigned short bf16_t;
typedef short bf16x8 __attribute__((ext_vector_type(8)));
typedef float f32x4 __attribute__((ext_vector_type(4)));
typedef unsigned u32x4 __attribute__((ext_vector_type(4)));
constexpr int BM = 256, BK = 64, HALF = 128, HTB = HALF * BK * 2  , STAGE_BYTES = 8 * HTB, NXCD = 8, WGM = 8;

__host__ __device__ __forceinline__ int lds_byte(int r, int c) { const int st = (r >> 4) * 2 + (c >> 5), rr = r & 15, cc = c & 31, ob = rr * 64 + cc * 2; return st * 1024 + (ob ^ (((ob >> 9) & 1) << 5)); }
__host__ __device__ __forceinline__ void stage_rc(int b, int& R, int& C) { const int st = b / 1024, sb = b % 1024, swz = sb ^ (((sb >> 9) & 1) << 5); R = (st >> 1) * 16 + swz / 64; C = (st & 1) * 32 + (swz % 64) / 2; }
__host__ __device__ __forceinline__ int perm32(int rho) { const int n = rho >> 4, i = rho & 15; return 8 * (i >> 2) + 4 * n + (i & 3); }

struct Unit { int pm, pn; };
struct Gemm { const bf16_t* A; const bf16_t* Bt; int M, N, K; };

struct StaticOrder {
    int nM, nN, nwg, G, c;
    __host__ __device__ void init(int M, int N, int G_, int c_) { nM = M / BM; nN = N / BM; nwg = nM * nN; G = G_; c = c_; }
    __host__ __device__ bool next(int i, Unit& u) const {
        const long L = (long)i * G + c; if (L >= nwg) return false;
        int wgid = (int)L; { const int q = nwg / NXCD, r = nwg % NXCD, xcd = wgid % NXCD, off = wgid / NXCD; wgid = (xcd < r ? xcd * (q + 1) : r * (q + 1) + (xcd - r) * q) + off; }
        const int nig = WGM * nN, gid = wgid / nig, fm = gid * WGM, gsz = (nM - fm) < WGM ? (nM - fm) : WGM;
        u.pm = fm + ((wgid % nig) % gsz); u.pn = (wgid % nig) / gsz; return true;
    }
    __device__ __forceinline__ void a_ready(const Unit&) const {}
    __device__ __forceinline__ void done(const Unit&) const {}
};

__device__ __forceinline__ unsigned cvt_pk_bf16(float lo, float hi) { unsigned r; asm volatile("v_cvt_pk_bf16_f32 %0, %1, %2" : "=v"(r) : "v"(lo), "v"(hi)); return r; }
typedef float f32x2 __attribute__((ext_vector_type(2)));
__device__ __forceinline__ f32x2 gelu_pk(f32x2 v) {
    const f32x2 av = __builtin_elementwise_abs(v), d = av * 0.2316418882f + 1.0f;
    f32x2 t; t.x = __builtin_amdgcn_rcpf(d.x); t.y = __builtin_amdgcn_rcpf(d.y);
    f32x2 q = t * 0.5307027145f + (-0.7265760135f); q = q * t + 0.7107068705f; q = q * t + (-0.142248368f); q = q * t + 0.127414796f; q = q * t;
    const f32x2 s = (v * v) * (-0.72134752044f);
    f32x2 e; e.x = __builtin_amdgcn_exp2f(s.x); e.y = __builtin_amdgcn_exp2f(s.y);
    const f32x2 m = v * (q * e), r = v - m;
    f32x2 o; o.x = v.x < 0.f ? m.x : r.x; o.y = v.y < 0.f ? m.y : r.y; return o;
}

__device__ __forceinline__ float fast_sigmoid(float x) { return __builtin_amdgcn_rcpf(1.f + __builtin_amdgcn_exp2f(-1.44269504089f * x)); }
__device__ __forceinline__ float bflo(unsigned w) { return __uint_as_float(w << 16); }
__device__ __forceinline__ float bfhi(unsigned w) { return __uint_as_float(w & 0xffff0000u); }
struct EpiIn {
    static constexpr bool PERM = true, AFTER_DRAIN = false;
    bf16_t *Prkv, *Plora, *Puv, *SG;
    __device__ __forceinline__ void operator()(const f32x4 (&acc)[2][2][4][2], const Unit& u, int wr, int wc, int fr, int fq) const {
        const int row0 = u.pm * BM + wr * 64 + fr;
        bf16_t* base; int ld, colt, act;
        if (u.pn < 6) { base = Prkv; ld = 1536; colt = u.pn * 256; act = 0; }
        else if (u.pn < 8) { base = Plora; ld = 512; colt = (u.pn - 6) * 256; act = 0; }
        else if (u.pn < 12) { base = Puv; ld = 1024; colt = (u.pn - 8) * 256; act = 1; }
        else { base = SG; ld = 2048; colt = (u.pn - 12) * 256; act = 2; }
        const int col0 = colt + wc * 32 + 8 * fq;
#pragma unroll
        for (int ai = 0; ai < 2; ++ai)
#pragma unroll
            for (int m = 0; m < 4; ++m) { bf16_t* rowp = base + (size_t)(row0 + ai * HALF + m * 16) * ld + col0;
#pragma unroll
                for (int bj = 0; bj < 2; ++bj) { f32x4 v0 = acc[ai][bj][m][0], v1 = acc[ai][bj][m][1];
                    if (act == 1) { f32x2 a = gelu_pk((f32x2){v0[0], v0[1]}), b = gelu_pk((f32x2){v0[2], v0[3]}), c = gelu_pk((f32x2){v1[0], v1[1]}), d = gelu_pk((f32x2){v1[2], v1[3]});
                        v0 = (f32x4){a.x, a.y, b.x, b.y}; v1 = (f32x4){c.x, c.y, d.x, d.y}; }
                    else if (act == 2) {
#pragma unroll
                        for (int i = 0; i < 4; ++i) { v0[i] = fast_sigmoid(v0[i]); v1[i] = fast_sigmoid(v1[i]); } }
                    u32x4 w; w.x = cvt_pk_bf16(v0[0], v0[1]); w.y = cvt_pk_bf16(v0[2], v0[3]); w.z = cvt_pk_bf16(v1[0], v1[1]); w.w = cvt_pk_bf16(v1[2], v1[3]);
                    *(u32x4*)(rowp + bj * HALF) = w; } }
    }
};
struct EpiGate {
    static constexpr bool PERM = true, AFTER_DRAIN = false;
    bf16_t* O; int ldo; const bf16_t* gate; int ldg; const bf16_t* add; int lda;
    __device__ __forceinline__ void operator()(const f32x4 (&acc)[2][2][4][2], const Unit& u, int wr, int wc, int fr, int fq) const {
        const int row0 = u.pm * BM + wr * 64 + fr, col0 = u.pn * BM + wc * 32 + 8 * fq;
#pragma unroll
        for (int ai = 0; ai < 2; ++ai)
#pragma unroll
            for (int m = 0; m < 4; ++m) { const size_t row = (size_t)(row0 + ai * HALF + m * 16);
#pragma unroll
                for (int bj = 0; bj < 2; ++bj) { const int col = col0 + bj * HALF;
                    const u32x4 gw = *(const u32x4*)(gate + row * ldg + col);
                    f32x4 v0 = acc[ai][bj][m][0], v1 = acc[ai][bj][m][1];
                    v0[0] *= bflo(gw.x); v0[1] *= bfhi(gw.x); v0[2] *= bflo(gw.y); v0[3] *= bfhi(gw.y);
                    v1[0] *= bflo(gw.z); v1[1] *= bfhi(gw.z); v1[2] *= bflo(gw.w); v1[3] *= bfhi(gw.w);
                    if (add) { const u32x4 aw = *(const u32x4*)(add + row * lda + col);
                        v0[0] += bflo(aw.x); v0[1] += bfhi(aw.x); v0[2] += bflo(aw.y); v0[3] += bfhi(aw.y);
                        v1[0] += bflo(aw.z); v1[1] += bfhi(aw.z); v1[2] += bflo(aw.w); v1[3] += bfhi(aw.w); }
                    u32x4 w; w.x = cvt_pk_bf16(v0[0], v0[1]); w.y = cvt_pk_bf16(v0[2], v0[3]); w.z = cvt_pk_bf16(v1[0], v1[1]); w.w = cvt_pk_bf16(v1[2], v1[3]);
                    *(u32x4*)(O + row * ldo + col) = w; } }
    }
};
struct EpiRes {
    static constexpr bool PERM = false, AFTER_DRAIN = false;
    const float* res; float* out; const float* gvec;
    __device__ __forceinline__ void operator()(const f32x4 (&acc)[2][2][4][2], const Unit& u, int wr, int wc, int fr, int fq) const {
        const int row0 = u.pm * BM + wr * 64 + fr, col0 = u.pn * BM + wc * 32 + 4 * fq;
        const float* gv = gvec + (u.pm >> 5) * 6144;
        f32x4 g4[2][2];
#pragma unroll
        for (int bj = 0; bj < 2; ++bj)
#pragma unroll
            for (int n = 0; n < 2; ++n) g4[bj][n] = *(const f32x4*)(gv + col0 + bj * HALF + n * 16);
#pragma unroll
        for (int ai = 0; ai < 2; ++ai)
#pragma unroll
            for (int m = 0; m < 4; ++m) { const size_t off = (size_t)(row0 + ai * HALF + m * 16) * 1024 + col0;
#pragma unroll
                for (int bj = 0; bj < 2; ++bj)
#pragma unroll
                    for (int n = 0; n < 2; ++n) { const f32x4 r = *(const f32x4*)(res + off + bj * HALF + n * 16);
                        *(f32x4*)(out + off + bj * HALF + n * 16) = r + g4[bj][n] * acc[ai][bj][m][n]; } }
    }
};
struct EpiSwiGLU {
    static constexpr bool PERM = true, AFTER_DRAIN = false;
    bf16_t* O; int ldo;
    __device__ __forceinline__ void operator()(const f32x4 (&acc)[2][2][4][2], const Unit& u, int wr, int wc, int fr, int fq) const {
        const int row0 = u.pm * BM + wr * 64 + fr, col0 = u.pn * HALF + wc * 32 + 8 * fq;
#pragma unroll
        for (int ai = 0; ai < 2; ++ai)
#pragma unroll
            for (int m = 0; m < 4; ++m) { bf16_t* rowp = O + (size_t)(row0 + ai * HALF + m * 16) * ldo + col0;
                f32x4 v[2];
#pragma unroll
                for (int n = 0; n < 2; ++n) { const f32x4 gt = acc[ai][0][m][n], up = acc[ai][1][m][n];
#pragma unroll
                    for (int i = 0; i < 4; ++i) v[n][i] = gt[i] * fast_sigmoid(gt[i]) * up[i]; }
                u32x4 w; w.x = cvt_pk_bf16(v[0][0], v[0][1]); w.y = cvt_pk_bf16(v[0][2], v[0][3]); w.z = cvt_pk_bf16(v[1][0], v[1][1]); w.w = cvt_pk_bf16(v[1][2], v[1][3]);
                *(u32x4*)rowp = w; }
    }
};
template <class Epi, class Sched, bool ALIGN_EPI = false, bool SP2 = false>
__device__ __forceinline__ void gemm_phase(PG8_LAS unsigned char* lds, const Gemm g, const Sched& S, const Epi& E) {
    int tid_ = threadIdx.x; asm volatile("" : "+v"(tid_));
    const int tid = tid_, wid = __builtin_amdgcn_readfirstlane(tid >> 6), lane = tid & 63, wr = wid >> 2, wc = wid & 3, fr = lane & 15, fq = lane >> 4;
    const int K = g.K, nt = K / BK;
    unsigned voffA[2], voffB[2];
#pragma unroll
    for (int i = 0; i < 2; ++i) { int R, C; stage_rc(tid * 16 + i * 8192, R, C); const int Rb = Epi::PERM ? ((R & ~31) + perm32(R & 31)) : R;
        voffA[i] = (unsigned)(R * K + C) * 2u; voffB[i] = (unsigned)(Rb * K + C) * 2u; }
    const size_t kstep = (size_t)(BK * 2);
    const size_t hstep = (size_t)HALF * K * 2;
    const size_t tstep = 2 * hstep;
    const unsigned ldsw = (unsigned)wid * 1024u;
    const int aoff = lds_byte(wr * 64 + fr, fq * 8), boff = lds_byte(wc * 32 + fr, fq * 8);
#define PG8_SA(b, h) (((b) * 2 + (h)) * HTB)
#define PG8_SB(b, h) ((4 + (b) * 2 + (h)) * HTB)
#define PG8_STAGE(bufoff, gbase, voff) do { _Pragma("unroll") for (int _i = 0; _i < 2; ++_i) \
        __builtin_amdgcn_global_load_lds((const unsigned*)((const char*)(gbase) + (voff)[_i]), (PG8_LAS unsigned*)(lds + (bufoff) + ldsw + _i * 8192), 16, 0, 0); } while (0)
#define PG8_LDA(dst, b, h) do { _Pragma("unroll") for (int m = 0; m < 4; ++m) _Pragma("unroll") for (int k = 0; k < 2; ++k) dst[m][k] = *(const PG8_LAS bf16x8*)(lds + PG8_SA(b, h) + aoff + m * 2048 + k * 1024); } while (0)
#define PG8_LDB(dst, b, h) do { _Pragma("unroll") for (int n = 0; n < 2; ++n) _Pragma("unroll") for (int k = 0; k < 2; ++k) dst[n][k] = *(const PG8_LAS bf16x8*)(lds + PG8_SB(b, h) + boff + n * 2048 + k * 1024); } while (0)
#define PG8_MMA(ai, bj, At, Bt) do { __builtin_amdgcn_s_setprio(1); _Pragma("unroll") for (int m = 0; m < 4; ++m) _Pragma("unroll") for (int n = 0; n < 2; ++n) _Pragma("unroll") for (int k = 0; k < 2; ++k) \
        acc[ai][bj][m][n] = __builtin_amdgcn_mfma_f32_16x16x32_bf16(Bt[n][k], At[m][k], acc[ai][bj][m][n], 0, 0, 0); __builtin_amdgcn_s_setprio(0); } while (0)
#define PG8_WAIT_V(n) asm volatile("s_waitcnt vmcnt(" #n ")" ::: "memory")
#define PG8_WAIT_L(n) asm volatile("s_waitcnt lgkmcnt(" #n ")" ::: "memory")
#define PG8_BAR __builtin_amdgcn_s_barrier()
#define PG8_SCHED __builtin_amdgcn_sched_barrier(0)
    Unit cur, nxt; int ui = 0;
    if (!S.next(0, cur)) return;
    f32x4 acc[2][2][4][2];
#pragma unroll
    for (int a = 0; a < 2; ++a)
#pragma unroll
        for (int b = 0; b < 2; ++b)
#pragma unroll
            for (int m = 0; m < 4; ++m)
#pragma unroll
                for (int n = 0; n < 2; ++n) acc[a][b][m][n] = (f32x4){0.f, 0.f, 0.f, 0.f};
    bf16x8 At[4][2], B0[2][2], B1[2][2];
    const char* cA = (const char*)g.A + (size_t)cur.pm * tstep; const char* cB = (const char*)g.Bt + (size_t)cur.pn * tstep;
    S.a_ready(cur);
    if constexpr (SP2) {
        PG8_STAGE(PG8_SB(0, 0), cB, voffB); PG8_STAGE(PG8_SB(0, 1), cB + hstep, voffB); PG8_STAGE(PG8_SA(0, 0), cA, voffA); PG8_STAGE(PG8_SA(0, 1), cA + hstep, voffA);
        if (wr == 1) PG8_BAR;
        PG8_WAIT_V(2); PG8_BAR;
        PG8_STAGE(PG8_SB(1, 0), cB + kstep, voffB); PG8_STAGE(PG8_SA(1, 0), cA + kstep, voffA); PG8_STAGE(PG8_SB(1, 1), cB + hstep + kstep, voffB);
        PG8_WAIT_V(6); PG8_BAR;
    } else {
        PG8_STAGE(PG8_SB(0, 0), cB, voffB); PG8_STAGE(PG8_SA(0, 0), cA, voffA); PG8_STAGE(PG8_SB(0, 1), cB + hstep, voffB); PG8_STAGE(PG8_SA(0, 1), cA + hstep, voffA);
        if (wr == 1) PG8_BAR;
        PG8_WAIT_V(4); PG8_BAR;
        PG8_STAGE(PG8_SB(1, 0), cB + kstep, voffB); PG8_STAGE(PG8_SA(1, 0), cA + kstep, voffA); PG8_STAGE(PG8_SB(1, 1), cB + hstep + kstep, voffB);
        PG8_WAIT_V(6); PG8_BAR;
    }
    for (;;) {
        const bool has_next = S.next(ui + 1, nxt);
        const char* nA = has_next ? (const char*)g.A + (size_t)nxt.pm * tstep : cA; const char* nB = has_next ? (const char*)g.Bt + (size_t)nxt.pn * tstep : cB;
        for (int t = 0; t < nt; t += 2) {
            const bool last = (t == nt - 2);
            const char* a1 = cA + (size_t)(t + 1) * kstep;
            const char* a2 = last ? nA : cA + (size_t)(t + 2) * kstep; const char* b2 = last ? nB : cB + (size_t)(t + 2) * kstep;
            const char* a3 = a2 + kstep; const char* b3 = b2 + kstep;
            if (last && has_next) S.a_ready(nxt);
            if constexpr (SP2) {
            PG8_LDB(B0, 0, 0); PG8_LDB(B1, 0, 1); PG8_SCHED; PG8_LDA(At, 0, 0); PG8_STAGE(PG8_SA(1, 1), a1 + hstep, voffA);
            PG8_WAIT_V(8); PG8_WAIT_L(0); PG8_BAR; PG8_MMA(0, 0, At, B0); PG8_MMA(0, 1, At, B1); PG8_BAR; PG8_SCHED;
            PG8_LDA(At, 0, 1); PG8_STAGE(PG8_SB(0, 0), b2, voffB); PG8_STAGE(PG8_SB(0, 1), b2 + hstep, voffB); PG8_STAGE(PG8_SA(0, 0), a2, voffA);
            PG8_WAIT_V(8); PG8_WAIT_L(0); PG8_BAR; PG8_MMA(1, 0, At, B0); PG8_MMA(1, 1, At, B1); PG8_BAR; PG8_SCHED;
            PG8_LDB(B0, 1, 0); PG8_LDB(B1, 1, 1); PG8_SCHED; PG8_LDA(At, 1, 0); PG8_STAGE(PG8_SA(0, 1), a2 + hstep, voffA);
            PG8_WAIT_V(8); PG8_WAIT_L(0); PG8_BAR; PG8_MMA(0, 0, At, B0); PG8_MMA(0, 1, At, B1); PG8_BAR; PG8_SCHED;
            PG8_LDA(At, 1, 1); PG8_STAGE(PG8_SB(1, 0), b3, voffB); PG8_STAGE(PG8_SB(1, 1), b3 + hstep, voffB); PG8_STAGE(PG8_SA(1, 0), a3, voffA);
            PG8_WAIT_V(8); PG8_WAIT_L(0); PG8_BAR; PG8_MMA(1, 0, At, B0); PG8_MMA(1, 1, At, B1); PG8_BAR; PG8_SCHED;
            } else {
            PG8_LDB(B0, 0, 0); PG8_SCHED; PG8_LDA(At, 0, 0); PG8_STAGE(PG8_SA(1, 1), a1 + hstep, voffA);
            PG8_WAIT_L(8); PG8_BAR; PG8_WAIT_L(0); PG8_MMA(0, 0, At, B0); PG8_BAR; PG8_SCHED;
            PG8_LDB(B1, 0, 1); PG8_STAGE(PG8_SB(0, 0), b2, voffB);
            PG8_BAR; PG8_WAIT_L(0); PG8_MMA(0, 1, At, B1); PG8_BAR;
            PG8_LDA(At, 0, 1); PG8_STAGE(PG8_SA(0, 0), a2, voffA);
            PG8_BAR; PG8_WAIT_L(0); PG8_MMA(1, 0, At, B0); PG8_BAR; PG8_SCHED;
            PG8_STAGE(PG8_SB(0, 1), b2 + hstep, voffB);
            PG8_WAIT_V(6); PG8_BAR; PG8_MMA(1, 1, At, B1); PG8_BAR;
            PG8_LDB(B0, 1, 0); PG8_SCHED; PG8_LDA(At, 1, 0); PG8_STAGE(PG8_SA(0, 1), a2 + hstep, voffA);
            PG8_WAIT_L(8); PG8_BAR; PG8_WAIT_L(0); PG8_MMA(0, 0, At, B0); PG8_BAR; PG8_SCHED;
            PG8_LDB(B1, 1, 1); PG8_STAGE(PG8_SB(1, 0), b3, voffB);
            PG8_BAR; PG8_WAIT_L(0); PG8_MMA(0, 1, At, B1); PG8_BAR;
            PG8_LDA(At, 1, 1); PG8_STAGE(PG8_SA(1, 0), a3, voffA);
            PG8_BAR; PG8_WAIT_L(0); PG8_MMA(1, 0, At, B0); PG8_BAR; PG8_SCHED;
            PG8_STAGE(PG8_SB(1, 1), b3 + hstep, voffB);
            PG8_WAIT_V(6); PG8_BAR; PG8_MMA(1, 1, At, B1); PG8_BAR;
            }
        }
        if constexpr (ALIGN_EPI) { if (wr == 0) PG8_BAR; }
        if constexpr (!Epi::AFTER_DRAIN) { E(acc, cur, wr, wc, fr, fq); S.done(cur); }
        if (!has_next) break;
#pragma unroll
        for (int a = 0; a < 2; ++a)
#pragma unroll
            for (int b = 0; b < 2; ++b)
#pragma unroll
                for (int m = 0; m < 4; ++m)
#pragma unroll
                    for (int n = 0; n < 2; ++n) acc[a][b][m][n] = (f32x4){0.f, 0.f, 0.f, 0.f};
        cur = nxt; cA = nA; cB = nB; ++ui;
        if constexpr (ALIGN_EPI) { if (wr == 1) PG8_BAR; }
    }
    PG8_WAIT_V(0);
    if constexpr (!ALIGN_EPI) { if (wr == 0) PG8_BAR; }
    PG8_BAR;
    if constexpr (Epi::AFTER_DRAIN) { E.fused(acc, cur, wr, wc, fr, fq, lds, wid, lane); S.done(cur); }
#undef PG8_SA
#undef PG8_SB
#undef PG8_STAGE
#undef PG8_LDA
#undef PG8_LDB
#undef PG8_MMA
#undef PG8_WAIT_V
#undef PG8_WAIT_L
#undef PG8_BAR
#undef PG8_SCHED
}
}
constexpr int NWAVES = 8;
constexpr int BATCH = 2, SEQ = 8192, D = 1024, M = BATCH * SEQ;
constexpr int RW = 512, NH = 8, HD = 64;
constexpr int FF = 2816;
constexpr int IN_COLS = 4896, IN_PAD = 5120;
constexpr size_t MiB = 1u << 20;
constexpr size_t WS_CTL = 0, CTL_ZERO_BYTES = 1 * MiB, WS_MOD = 1 * MiB;
constexpr size_t WS_WIN = 2 * MiB, WS_WFFI = 12 * MiB, WS_WFFO = 23 * MiB, WS_WOUT = 29 * MiB, WS_WA = 31 * MiB, WS_WB = 32 * MiB;
constexpr size_t WS_H = 34 * MiB, WS_PRKV = 66 * MiB, WS_PLORA = 114 * MiB, WS_PUV = 130 * MiB, WS_SG = 162 * MiB, WS_TAIL = 226 * MiB, WS_END = 256 * MiB;
constexpr size_t WS_YB = 34 * MiB, WS_RT = 50 * MiB, WS_AT = 130 * MiB, WS_BT = 146 * MiB, WS_KT = 226 * MiB, WS_CDX = 66 * MiB, WS_CDY = 98 * MiB, WS_XS = 50 * MiB, WS_YA = 226 * MiB,
                 WS_M1 = 130 * MiB, WS_MERGED = 66 * MiB, WS_H2 = 34 * MiB, WS_ACT = 66 * MiB;
constexpr size_t OUT_VT = 0, OUT_G = 16 * MiB, OUT_BON = 32 * MiB, OUT_GC = 48 * MiB;
constexpr int CW_TMO = 0, CW_CODE = 1, CW_BAR = 4096;
constexpr int RING_OFF = 0, RING_BYTES = 131072, LDSCTL_OFF = RING_BYTES, MISC_OFF = LDSCTL_OFF + 320, LDS_BYTES = 147456;

#define GAS __attribute__((address_space(1)))
#define LAS __attribute__((address_space(3)))
typedef unsigned short bf16;
typedef unsigned v4u __attribute__((ext_vector_type(4)));
typedef unsigned v2u __attribute__((ext_vector_type(2)));
typedef float f32x4 __attribute__((ext_vector_type(4)));
typedef GAS unsigned gu32;
#define RLX_AGENT __ATOMIC_RELAXED, __HIP_MEMORY_SCOPE_AGENT
#define LDS_WAIT() asm volatile("s_waitcnt lgkmcnt(0)" ::: "memory")
__device__ __forceinline__ unsigned f2bf(float f) { unsigned u = __builtin_bit_cast(unsigned, f); return (u + 0x7fffu + ((u >> 16) & 1u)) >> 16; }
__device__ __forceinline__ unsigned pk2(float lo, float hi) { return f2bf(lo) | (f2bf(hi) << 16); }
__device__ __forceinline__ float bf2f(bf16 v) { return __uint_as_float(((unsigned)v) << 16); }
__device__ __forceinline__ float bflo(unsigned w) { return __uint_as_float(w << 16); }
__device__ __forceinline__ float bfhi(unsigned w) { return __uint_as_float(w & 0xffff0000u); }
__device__ __forceinline__ float sigmoidf_(float x) { return 1.f / (1.f + __expf(-x)); }
__device__ __forceinline__ float softplusf_(float x) { return x > 20.f ? x : log1pf(expf(x)); }
__device__ __forceinline__ float wave_sum(float v) {
#pragma unroll
    for (int o = 1; o < 64; o <<= 1) v += __shfl_xor(v, o);
    return v;
}
#define XB_TMO      128
#define XB_XCNT(j)  (256  + 64 * (j))
#define XB_XSUB(j)  (1280 + 64 * (j))
#define XB_XGEN(j)  (2304 + 64 * (j))
#define XB_TOP      3328
#define XB_TOPGEN   3392
#define XCD_BAR_WORDS 3456
#define XB_SPIN_CAP (1u << 18)

__device__ __forceinline__ unsigned xb_ld(unsigned* p)              { return __hip_atomic_load(p, __ATOMIC_RELAXED, __HIP_MEMORY_SCOPE_AGENT); }
__device__ __forceinline__ unsigned xb_add(unsigned* p, unsigned v) { return __hip_atomic_fetch_add(p, v, __ATOMIC_RELAXED, __HIP_MEMORY_SCOPE_AGENT); }
__device__ __forceinline__ unsigned xb_xcc_id() { return (unsigned)__builtin_amdgcn_s_getreg((3 << 11) | 20) & 0xFu; }
#define XB_SPIN(cond, bar) do { unsigned _sp = 0; while (cond) { __builtin_amdgcn_s_sleep(1); \
    if ((++_sp & 255u) == 0u) { if (xb_ld(&(bar)[XB_TMO])) break; if (_sp > XB_SPIN_CAP) { atomicAdd(&(bar)[XB_TMO], 1u); break; } } } } while (0)

struct XcdBarrier {
    unsigned* bar; unsigned x;
    volatile LAS unsigned* st;
};

__device__ __forceinline__ XcdBarrier xcd_barrier_post(unsigned* bar, volatile LAS unsigned* st) {
    XcdBarrier b; b.bar = bar; b.x = xb_xcc_id(); b.st = st;
    if (threadIdx.x == 0) (void)xb_add(&bar[XB_XCNT(b.x)], 1u);
    return b;
}
__device__ __forceinline__ void xcd_barrier_complete(unsigned* bar, unsigned x, unsigned& nloc, unsigned& nx) {
    const unsigned G = gridDim.x * gridDim.y * gridDim.z;
    unsigned sum, cnt, mine, sp = 0u;
    for (;;) {
        sum = 0u; cnt = 0u; mine = 0u;
#pragma unroll
        for (unsigned j = 0; j < 16; ++j) { const unsigned c = xb_ld(&bar[XB_XCNT(j)]); sum += c; cnt += (c > 0u) ? 1u : 0u; mine = (j == x) ? c : mine; }
        if (sum == G) break;
        __builtin_amdgcn_s_sleep(1);
        if ((++sp & 255u) == 0u) { if (xb_ld(&bar[XB_TMO])) break; if (sp > XB_SPIN_CAP) { atomicAdd(&bar[XB_TMO], 1u); break; } }
    }
    nloc = mine > 0u ? mine : 1u; nx = cnt > 0u ? cnt : 1u;
}

__device__ __forceinline__ void xcd_barrier(const XcdBarrier& b) {
    asm volatile("s_waitcnt vmcnt(0)" ::: "memory");
    __syncthreads();
    if (threadIdx.x == 0) {
        unsigned* bar = b.bar;
        __builtin_amdgcn_s_waitcnt(0);
        unsigned nloc = b.st[0], nx = b.st[1];
        if (nloc == 0u) { xcd_barrier_complete(bar, b.x, nloc, nx); b.st[0] = nloc; b.st[1] = nx; }
        const unsigned old = xb_add(&bar[XB_XSUB(b.x)], 1u);
        const unsigned gen = old / nloc;
        if (old + 1u == (gen + 1u) * nloc) {
            __builtin_amdgcn_fence(__ATOMIC_RELEASE, "agent");
            asm volatile("s_waitcnt vmcnt(0)" ::: "memory");
            const unsigned og = xb_add(&bar[XB_TOP], 1u);
            const unsigned tg = og / nx;
            if (og + 1u == (tg + 1u) * nx) xb_add(&bar[XB_TOPGEN], 1u);
            else XB_SPIN(xb_ld(&bar[XB_TOPGEN]) == tg, bar);
            __builtin_amdgcn_fence(__ATOMIC_ACQUIRE, "agent");
            xb_add(&bar[XB_XGEN(b.x)], 1u);
            asm volatile("s_waitcnt vmcnt(0)" ::: "memory");
        } else {
            XB_SPIN(xb_ld(&bar[XB_XGEN(b.x)]) == gen, bar);
            __builtin_amdgcn_fence(__ATOMIC_ACQUIRE, "agent");
            asm volatile("s_waitcnt vmcnt(0)" ::: "memory");
        }
    }
    __syncthreads();
}
struct Args {
    const float *x, *c, *w_ada, *b_ada, *norm1_g, *norm2_g, *normf_g, *w_in, *mu, *w0, *wdu, *a0, *wau, *wgu, *k_k, *k_a, *r_k, *lnx_g, *lnx_b, *gln_g, *gln_b, *w_sp, *b_sp, *w_ba, *w_bb, *w_out, *w_fi, *w_fo;
    float* out; unsigned char* ws; int ph_lo, ph_hi;
};
struct Frame { LAS unsigned char* lds; volatile LAS unsigned* MISC; gu32* ctl; int tid, lane, wave, vcu, G; };

__device__ __forceinline__ void mod_item(const Args& a, float* mod, int item, int lane) {
    const int n0 = item * 16, kg = lane >> 2, cq = lane & 3;
    f32x4 acc0 = {0.f, 0.f, 0.f, 0.f}, acc1 = {0.f, 0.f, 0.f, 0.f};
#pragma unroll 8
    for (int i = 0; i < 64; ++i) { const int k = kg + 16 * i;
        const f32x4 w = *(const f32x4*)(a.w_ada + (size_t)k * (6 * D) + n0 + 4 * cq);
        const float c0 = a.c[k], c1 = a.c[D + k];
        const float s0 = c0 / (1.f + __expf(-c0)), s1 = c1 / (1.f + __expf(-c1));
        acc0 += s0 * w; acc1 += s1 * w; }
#pragma unroll
    for (int o = 4; o < 64; o <<= 1)
#pragma unroll
        for (int j = 0; j < 4; ++j) { acc0[j] += __shfl_xor(acc0[j], o); acc1[j] += __shfl_xor(acc1[j], o); }
    if (kg == 0) { const f32x4 b = *(const f32x4*)(a.b_ada + n0 + 4 * cq);
        *(f32x4*)(mod + n0 + 4 * cq) = acc0 + b; *(f32x4*)(mod + 6 * D + n0 + 4 * cq) = acc1 + b; }
}
__device__ __forceinline__ void transpose_item(const float* W, int ldw, int s0, int K, bf16* WT, int d0, int k0, LAS float* scr, int lane) {
    if (s0 >= 0) {
#pragma unroll 8
        for (int i = 0; i < 32; ++i) { const int kk = 2 * i + (lane >> 5); scr[kk * 33 + (lane & 31)] = W[(size_t)(k0 + kk) * ldw + s0 + (lane & 31)]; }
    } else {
#pragma unroll 8
        for (int i = 0; i < 32; ++i) { const int kk = 2 * i + (lane >> 5); scr[kk * 33 + (lane & 31)] = 0.f; }
    }
    LDS_WAIT(); asm volatile("" ::: "memory");
    const int c = lane & 7;
#pragma unroll
    for (int j = 0; j < 4; ++j) { const int n = (lane >> 3) + 8 * j; const LAS float* s = scr + (8 * c) * 33 + n;
        v4u o; o.x = pk2(s[0 * 33], s[1 * 33]); o.y = pk2(s[2 * 33], s[3 * 33]); o.z = pk2(s[4 * 33], s[5 * 33]); o.w = pk2(s[6 * 33], s[7 * 33]);
        *(GAS v4u*)(WT + (size_t)(d0 + n) * K + k0 + 8 * c) = o; }
    LDS_WAIT(); asm volatile("" ::: "memory");
}
__device__ __forceinline__ void p0_prologue(const Args& a, Frame& F) {
    LAS float* scr = (LAS float*)(F.lds + RING_OFF + F.wave * 16384);
    const int gw = F.vcu * NWAVES + F.wave, NGW = F.G * NWAVES;
    unsigned char* ws = a.ws;
    float* mod = (float*)(ws + WS_MOD);
    for (int it = gw; it < 6 * D / 16; it += NGW) mod_item(a, mod, it, F.lane);
    constexpr int I_IN = 16 * 160, I_FFI = 16 * 176, I_FFO = 44 * 32, I_OUT = 16 * 32, I_BR = 8 * 32;
    constexpr int NITEMS = I_IN + I_FFI + I_FFO + I_OUT + 2 * I_BR;
    for (int it = gw; it < NITEMS; it += NGW) {
        int r = it;
        if (r < I_IN) { const int kb = r / 160, rb = r % 160, d0 = 32 * rb; const int s0 = d0 < 1824 ? d0 : (d0 < 2048 ? -1 : d0 - 224);
            transpose_item(a.w_in, IN_COLS, s0, D, (bf16*)(ws + WS_WIN), d0, 64 * kb, scr, F.lane); continue; } r -= I_IN;
        if (r < I_FFI) { const int kb = r / 176, rb = r % 176, d0 = 32 * rb, pn = d0 >> 8, w = d0 & 255; const int s0 = w < 128 ? 128 * pn + w : FF + 128 * pn + (w - 128);
            transpose_item(a.w_fi, 2 * FF, s0, D, (bf16*)(ws + WS_WFFI), d0, 64 * kb, scr, F.lane); continue; } r -= I_FFI;
        if (r < I_FFO) { const int kb = r / 32, rb = r % 32; transpose_item(a.w_fo, D, 32 * rb, FF, (bf16*)(ws + WS_WFFO), 32 * rb, 64 * kb, scr, F.lane); continue; } r -= I_FFO;
        if (r < I_OUT) { const int kb = r / 32, rb = r % 32; transpose_item(a.w_out, D, 32 * rb, D, (bf16*)(ws + WS_WOUT), 32 * rb, 64 * kb, scr, F.lane); continue; } r -= I_OUT;
        if (r < I_BR) { const int kb = r / 32, rb = r % 32; transpose_item(a.w_ba, D, 32 * rb, RW, (bf16*)(ws + WS_WA), 32 * rb, 64 * kb, scr, F.lane); continue; } r -= I_BR;
        { const int kb = r / 32, rb = r % 32; transpose_item(a.w_bb, D, 32 * rb, RW, (bf16*)(ws + WS_WB), 32 * rb, 64 * kb, scr, F.lane); }
    }
}
__device__ __forceinline__ void rmsnorm_mod_rows(const float* x, const float* g, const float* mod, int sh_off, int sc_off, bf16* out, Frame& F) {
    const int gw = F.vcu * NWAVES + F.wave, NGW = F.G * NWAVES;
    for (int row = gw; row < M; row += NGW) {
        const f32x4* xr = (const f32x4*)(x + (size_t)row * D) + F.lane;
        f32x4 v[4]; float s = 0.f;
#pragma unroll
        for (int j = 0; j < 4; ++j) { v[j] = xr[64 * j]; s += (v[j].x * v[j].x + v[j].y * v[j].y) + (v[j].z * v[j].z + v[j].w * v[j].w); }
        const float rstd = 1.0f / sqrtf(wave_sum(s) * (1.f / D) + 1e-6f);
        const float* mb = mod + (row / SEQ) * 6 * D;
        unsigned long long* o8 = (unsigned long long*)(out + (size_t)row * D) + F.lane;
#pragma unroll
        for (int j = 0; j < 4; ++j) { const f32x4 gv = ((const f32x4*)g)[F.lane + 64 * j], sh = ((const f32x4*)(mb + sh_off))[F.lane + 64 * j], sc = ((const f32x4*)(mb + sc_off))[F.lane + 64 * j];
            const f32x4 y = v[j] * rstd * gv * (1.f + sc) + sh;
            o8[64 * j] = (unsigned long long)pk2(y.x, y.y) | ((unsigned long long)pk2(y.z, y.w) << 32); }
    }
}
__device__ __forceinline__ void rmsnorm_final_rows(float* x, const float* g, Frame& F) {
    const int gw = F.vcu * NWAVES + F.wave, NGW = F.G * NWAVES;
    for (int row = gw; row < M; row += NGW) {
        f32x4* xr = (f32x4*)(x + (size_t)row * D) + F.lane;
        f32x4 v[4]; float s = 0.f;
#pragma unroll
        for (int j = 0; j < 4; ++j) { v[j] = xr[64 * j]; s += (v[j].x * v[j].x + v[j].y * v[j].y) + (v[j].z * v[j].z + v[j].w * v[j].w); }
        const float rstd = 1.0f / sqrtf(wave_sum(s) * (1.f / D) + 1e-6f);
#pragma unroll
        for (int j = 0; j < 4; ++j) xr[64 * j] = v[j] * rstd * ((const f32x4*)g)[F.lane + 64 * j];
    }
}
__device__ __forceinline__ void gmlp_units(const Args& a, Frame& F) {
    const bf16* Puv = (const bf16*)(a.ws + WS_PUV); bf16* YB = (bf16*)(a.ws + WS_YB);
    LAS float* vn = (LAS float*)(F.lds + RING_OFF);
    LAS float* wsl = (LAS float*)(F.lds + RING_OFF + 65536);
    (void)wsl;
    LAS float* stat = (LAS float*)(F.lds + RING_OFF + 65536);
    for (int unit = F.vcu; unit < (M / 128) * 4; unit += F.G) {
        const int g = unit & 3, row0 = (unit >> 2) * 128;
        for (int r = F.wave; r < 128; r += NWAVES) {
            const v4u w = *(const v4u*)(Puv + (size_t)(row0 + r) * 1024 + 512 + 8 * F.lane);
            const float v[8] = {bflo(w.x), bfhi(w.x), bflo(w.y), bfhi(w.y), bflo(w.z), bfhi(w.z), bflo(w.w), bfhi(w.w)};
            float s = 0.f;
#pragma unroll
            for (int j = 0; j < 8; ++j) s += v[j];
            const float mean = wave_sum(s) * (1.f / 512.f); float q = 0.f;
#pragma unroll
            for (int j = 0; j < 8; ++j) { const float d = v[j] - mean; q += d * d; }
            const float var = wave_sum(q) * (1.f / 512.f);
            if (F.lane == 0) { stat[2 * r] = mean; stat[2 * r + 1] = 1.0f / sqrtf(var + 1e-5f); }
        }
        __syncthreads();
        for (int i = F.tid; i < 128 * 128; i += NWAVES * 64) { const int r = i >> 7, d = i & 127, ch = g * 128 + d;
            vn[i] = (bf2f(Puv[(size_t)(row0 + r) * 1024 + 512 + ch]) - stat[2 * r]) * stat[2 * r + 1] * a.gln_g[ch] + a.gln_b[ch]; }
        __syncthreads();
        const int d = F.tid & 127, rg = F.tid >> 7;
        for (int ii = 0; ii < 8; ++ii) {
            const int i0 = 4 * (rg + 4 * ii), jmax = i0 < 64 ? 64 : 128;
            const float* wr = a.w_sp + ((size_t)g * 128 + i0) * 128;
            float acc[4] = {0.f, 0.f, 0.f, 0.f};
            for (int j = 0; j < jmax; j += 4) {
                const float v0 = vn[(j + 0) * 128 + d], v1 = vn[(j + 1) * 128 + d], v2 = vn[(j + 2) * 128 + d], v3 = vn[(j + 3) * 128 + d];
#pragma unroll
                for (int q = 0; q < 4; ++q) { const f32x4 w = *(const f32x4*)(wr + q * 128 + j); acc[q] += (w.x * v0 + w.y * v1) + (w.z * v2 + w.w * v3); }
            }
#pragma unroll
            for (int q = 0; q < 4; ++q) { const int i = i0 + q; const float sv = acc[q] + a.b_sp[g * 128 + i];
                const float u = bf2f(Puv[(size_t)(row0 + i) * 1024 + g * 128 + d]);
                YB[(size_t)(row0 + i) * 512 + g * 128 + d] = (bf16)f2bf(u * sv); }
        }
        __syncthreads();
    }
}
__device__ __forceinline__ void prep_units(const Args& a, Frame& F) {
    const bf16* Prkv = (const bf16*)(a.ws + WS_PRKV); const bf16* Plora = (const bf16*)(a.ws + WS_PLORA);
    bf16* AT = (bf16*)(a.ws + WS_AT); bf16* BT = (bf16*)(a.ws + WS_BT); bf16* KT = (bf16*)(a.ws + WS_KT); bf16* RT = (bf16*)(a.ws + WS_RT);
    bf16* VT = (bf16*)((unsigned char*)a.out + OUT_VT); bf16* G = (bf16*)((unsigned char*)a.out + OUT_G); bf16* BON = (bf16*)((unsigned char*)a.out + OUT_BON);
    float* GC = (float*)((unsigned char*)a.out + OUT_GC);
    LAS float* lin = (LAS float*)(F.lds + RING_OFF);
    const int c = F.tid;
    const float mur = a.mu[c], muk = a.mu[512 + c], muv = a.mu[1024 + c], w0c = a.w0[c], a0c = a.a0[c], kkc = a.k_k[c], kac = a.k_a[c], rkc = a.r_k[c];
    for (int unit = F.vcu; unit < M / 64; unit += F.G) {
        float cl = 0.f;
        for (int sub = 0; sub < 4; ++sub) {
            const int t0 = unit * 64 + sub * 16;
            for (int i = F.tid; i < 16 * 288; i += NWAVES * 64) {
                const int tt = i / 288, j = i % 288, t = t0 + tt;
                const float cur = bf2f(Plora[(size_t)t * 512 + j]);
                const float prev = (t % SEQ) == 0 ? 0.f : bf2f(Plora[(size_t)(t - 1) * 512 + j]);
                const float xs = cur + (prev - cur) * a.mu[1536 + j];
                lin[tt * 288 + j] = j < 64 ? tanhf(xs) : (j < 128 ? xs : sigmoidf_(xs));
            }
            __syncthreads();
            float dw[16], da[16], dg[16];
#pragma unroll
            for (int tt = 0; tt < 16; ++tt) { dw[tt] = 0.f; da[tt] = 0.f; dg[tt] = 0.f; }
            for (int j = 0; j < 64; ++j) { const float w = a.wdu[j * 512 + c];
#pragma unroll
                for (int tt = 0; tt < 16; ++tt) dw[tt] += lin[tt * 288 + j] * w; }
            for (int j = 0; j < 64; ++j) { const float w = a.wau[j * 512 + c];
#pragma unroll
                for (int tt = 0; tt < 16; ++tt) da[tt] += lin[tt * 288 + 64 + j] * w; }
            for (int j = 0; j < 160; ++j) { const float w = a.wgu[j * 512 + c];
#pragma unroll
                for (int tt = 0; tt < 16; ++tt) dg[tt] += lin[tt * 288 + 128 + j] * w; }
            float pr, pk, pv;
            if ((t0 % SEQ) == 0) { pr = 0.f; pk = 0.f; pv = 0.f; }
            else { pr = bf2f(Prkv[(size_t)(t0 - 1) * 1536 + c]); pk = bf2f(Prkv[(size_t)(t0 - 1) * 1536 + 512 + c]); pv = bf2f(Prkv[(size_t)(t0 - 1) * 1536 + 1024 + c]); }
#pragma unroll
            for (int tt = 0; tt < 16; ++tt) {
                const int t = t0 + tt;
                const float cr = bf2f(Prkv[(size_t)t * 1536 + c]), ck = bf2f(Prkv[(size_t)t * 1536 + 512 + c]), cv = bf2f(Prkv[(size_t)t * 1536 + 1024 + c]);
                const float r = cr + (pr - cr) * mur, k = ck + (pk - ck) * muk, v = cv + (pv - cv) * muv;
                pr = cr; pk = ck; pv = cv;
                const float wlog = -softplusf_(-(w0c + dw[tt])) - 0.5f;
                const float lw = -expf(wlog);
                const float av = sigmoidf_(a0c + da[tt]);
                float kk = k * kkc;
                const float nrm = sqrtf(wave_sum(kk * kk));
                kk = kk / fmaxf(nrm, 1e-12f);
                const float k2 = k * (1.f + (av - 1.f) * kac);
                const float bon = wave_sum(r * k2 * rkc) * v;
                const float gex = expf(cl); cl += lw; const float gin = expf(cl), ginv = expf(-cl);
                const size_t o = (size_t)t * 512 + c;
                AT[o] = (bf16)f2bf(-kk * gex); BT[o] = (bf16)f2bf(kk * av * ginv); KT[o] = (bf16)f2bf(k2 * ginv); RT[o] = (bf16)f2bf(r * gin); VT[o] = (bf16)f2bf(v);
                G[o] = (bf16)f2bf(dg[tt]); BON[o] = (bf16)f2bf(bon);
            }
            __syncthreads();
        }
        GC[(size_t)unit * 512 + c] = expf(cl);
    }
}
typedef short bf16x8 __attribute__((ext_vector_type(8)));
typedef float f32x16 __attribute__((ext_vector_type(16)));
constexpr int MS = 144, MB = 64 * MS;
constexpr int L_ATC = 0, L_BTC = 1 * MB, L_KTC = 2 * MB, L_RTC = 3 * MB, L_ACT = 4 * MB, L_BHCT = 5 * MB, L_KHCT = 6 * MB, L_VVT = 7 * MB,
              L_LAK = 8 * MB, L_MRB = 9 * MB, L_MRK = 10 * MB, L_TM = 11 * MB, L_LF = 12 * MB, L_L21 = 13 * MB, L_T11T = 13 * MB + 32 * MS,
              L_X1VT = L_ATC, L_WCT = L_KTC, L_U0VT = L_BTC, L_ZCT = L_LF;
static_assert(14 * MB <= RING_BYTES, "precompute LDS map");
__device__ __forceinline__ int cpos(int i) { return (i & 32) | (((i >> 2) & 3) << 3) | (((i >> 4) & 1) << 2) | (i & 3); }
__device__ __forceinline__ f32x16 mm32(LAS const unsigned char* A, int m0, LAS const unsigned char* Bt, int n0, int k0, int nk, f32x16 acc, int lane) {
    const int r = lane & 31, h = lane >> 5;
    LAS const unsigned char* ap = A + (m0 + r) * MS + (k0 + 8 * h) * 2;
    LAS const unsigned char* bp = Bt + (n0 + r) * MS + (k0 + 8 * h) * 2;
    for (int s = 0; s < nk; ++s) {
        const bf16x8 av = *(LAS const bf16x8*)(ap + 32 * s), bv = *(LAS const bf16x8*)(bp + 32 * s);
        acc = __builtin_amdgcn_mfma_f32_32x32x16_bf16(av, bv, acc, 0, 0, 0);
    }
    return acc;
}
template <int MASK>
__device__ __forceinline__ void st_t_bf16(LAS unsigned char* Z, const f32x16& acc, int m0, int n0, int lane) {
    const int r = lane & 31, h = lane >> 5, n = n0 + r;
#pragma unroll
    for (int q = 0; q < 4; ++q) { const int m = m0 + 8 * q + 4 * h; float v[4];
#pragma unroll
        for (int e = 0; e < 4; ++e) { v[e] = acc[4 * q + e]; if (MASK == 1 && !(m + e < n)) v[e] = 0.f; if (MASK == 2 && !(m + e <= n)) v[e] = 0.f; }
        v2u w; w.x = pk2(v[0], v[1]); w.y = pk2(v[2], v[3]);
        *(LAS v2u*)(Z + n * MS + m * 2) = w; }
}
__device__ __forceinline__ void precompute_units(const Args& a, Frame& F) {
    const bf16* AT = (const bf16*)(a.ws + WS_AT); const bf16* BT = (const bf16*)(a.ws + WS_BT); const bf16* KT = (const bf16*)(a.ws + WS_KT); const bf16* RT = (const bf16*)(a.ws + WS_RT);
    const bf16* VT = (const bf16*)((unsigned char*)a.out + OUT_VT); const float* GC = (const float*)((unsigned char*)a.out + OUT_GC);
    LAS unsigned char* L = F.lds + RING_OFF;
    const int w = F.wave;
    for (int i = F.tid; i < MB / 4; i += NWAVES * 64) ((LAS unsigned*)(L + L_TM))[i] = 0u;
    for (int bc = F.vcu; bc < M / 64; bc += F.G) {
        for (int h = 0; h < NH; ++h) {
            int tid = F.tid; asm volatile("" : "+v"(tid));
            const int lane = tid & 63, r = lane & 31, hh = lane >> 5;
            const int lt = tid >> 3, lc8 = tid & 7;
            { const size_t go = (size_t)(bc * 64 + lt) * 512 + h * 64 + 8 * lc8;
              const v4u va = *(const v4u*)(AT + go), vb = *(const v4u*)(BT + go), vk = *(const v4u*)(KT + go), vr = *(const v4u*)(RT + go), vv = *(const v4u*)(VT + go);
              const f32x4 g0 = *(const f32x4*)(GC + (size_t)bc * 512 + h * 64 + 8 * lc8), g1 = *(const f32x4*)(GC + (size_t)bc * 512 + h * 64 + 8 * lc8 + 4);
              const float gc[8] = {g0.x, g0.y, g0.z, g0.w, g1.x, g1.y, g1.z, g1.w};
              *(LAS v4u*)(L + L_ATC + lt * MS + 16 * lc8) = va; *(LAS v4u*)(L + L_BTC + lt * MS + 16 * lc8) = vb;
              *(LAS v4u*)(L + L_KTC + lt * MS + 16 * lc8) = vk; *(LAS v4u*)(L + L_RTC + lt * MS + 16 * lc8) = vr;
              const unsigned ua[4] = {va.x, va.y, va.z, va.w}, ub[4] = {vb.x, vb.y, vb.z, vb.w}, uk[4] = {vk.x, vk.y, vk.z, vk.w}, uv[4] = {vv.x, vv.y, vv.z, vv.w};
#pragma unroll
              for (int e = 0; e < 8; ++e) { const int cc = 8 * lc8 + e; const unsigned sh = (e & 1) ? 16u : 0u;
                  const unsigned ea = (ua[e >> 1] >> sh) & 0xffffu, eb = (ub[e >> 1] >> sh) & 0xffffu, ek = (uk[e >> 1] >> sh) & 0xffffu, ev = (uv[e >> 1] >> sh) & 0xffffu;
                  *(LAS bf16*)(L + L_ACT + cc * MS + lt * 2) = (bf16)ea;
                  *(LAS bf16*)(L + L_VVT + cc * MS + lt * 2) = (bf16)ev;
                  *(LAS bf16*)(L + L_BHCT + cc * MS + lt * 2) = (bf16)f2bf(__uint_as_float(eb << 16) * gc[e]);
                  *(LAS bf16*)(L + L_KHCT + cc * MS + lt * 2) = (bf16)f2bf(__uint_as_float(ek << 16) * gc[e]); }
            }
            __syncthreads();
            for (int task = w; task < 15; task += NWAVES) {
                const f32x16 z = {0.f, 0.f, 0.f, 0.f, 0.f, 0.f, 0.f, 0.f, 0.f, 0.f, 0.f, 0.f, 0.f, 0.f, 0.f, 0.f};
                if (task < 3) {
                    const int jb = task == 1 ? 1 : 0, ib = task == 0 ? 0 : 1;
                    const f32x16 acc = mm32(L + L_BTC, 32 * jb, L + L_ATC, 32 * ib, 0, 4, z, lane);
                    if (task < 2) {
#pragma unroll
                        for (int q = 0; q < 4; ++q) { const int m = 8 * q + 4 * hh; f32x4 v;
#pragma unroll
                            for (int e = 0; e < 4; ++e) v[e] = (m + e < r) ? acc[4 * q + e] : 0.f;
                            *(LAS f32x4*)(L + L_LF + task * (32 * MS) + r * MS + m * 4) = v; }
                    } else st_t_bf16<0>(L + L_L21, acc, 0, 0, lane);
                } else {
                    const int k2 = (task - 3) >> 2, tile = (task - 3) & 3, jb = tile >> 1, tb = tile & 1;
                    if (k2 == 0) { const f32x16 acc = mm32(L + L_KTC, 32 * jb, L + L_ATC, 32 * tb, 0, 4, z, lane); st_t_bf16<1>(L + L_LAK, acc, 32 * jb, 32 * tb, lane); }
                    else if (k2 == 1) { const f32x16 acc = mm32(L + L_BTC, 32 * jb, L + L_RTC, 32 * tb, 0, 4, z, lane); st_t_bf16<2>(L + L_MRB, acc, 32 * jb, 32 * tb, lane); }
                    else { const f32x16 acc = mm32(L + L_KTC, 32 * jb, L + L_RTC, 32 * tb, 0, 4, z, lane); st_t_bf16<2>(L + L_MRK, acc, 32 * jb, 32 * tb, lane); }
                }
            }
            __syncthreads();
            if (w == 0) {
                float t[32];
                LAS const unsigned char* lf = L + L_LF + hh * (32 * MS);
#pragma unroll
                for (int i = 0; i < 32; ++i) {
                    float s = (i == r) ? 1.f : 0.f;
#pragma unroll
                    for (int jj = 0; jj < (i + 3) / 4; ++jj) { const f32x4 l4 = *(LAS const f32x4*)(lf + i * MS + 16 * jj);
#pragma unroll
                        for (int e = 0; e < 4; ++e) if (4 * jj + e < i) s += l4[e] * t[4 * jj + e]; }
                    t[i] = s;
                }
#pragma unroll
                for (int i = 0; i < 32; ++i) *(LAS bf16*)(L + L_TM + (32 * hh + i) * MS + (32 * hh + r) * 2) = (bf16)f2bf(t[i]);
                if (hh == 0) {
#pragma unroll
                    for (int k = 0; k < 4; ++k) { v4u o; o.x = pk2(t[8 * k], t[8 * k + 1]); o.y = pk2(t[8 * k + 2], t[8 * k + 3]); o.z = pk2(t[8 * k + 4], t[8 * k + 5]); o.w = pk2(t[8 * k + 6], t[8 * k + 7]);
                        *(LAS v4u*)(L + L_T11T + r * MS + 16 * k) = o; }
                }
                LDS_WAIT(); asm volatile("" ::: "memory");
                const f32x16 z = {0.f, 0.f, 0.f, 0.f, 0.f, 0.f, 0.f, 0.f, 0.f, 0.f, 0.f, 0.f, 0.f, 0.f, 0.f, 0.f};
                { const f32x16 acc = mm32(L + L_L21, 0, L + L_T11T, 0, 0, 2, z, lane); st_t_bf16<0>(L + L_ZCT, acc, 0, 0, lane); }
                LDS_WAIT(); asm volatile("" ::: "memory");
                { const f32x16 acc = mm32(L + L_ZCT, 0, L + L_TM + 32 * MS + 64, 0, 0, 2, z, lane); st_t_bf16<0>(L + L_TM + 32 * MS, acc, 0, 0, lane); }
            } else if (w <= 4) {
                const int tile = w - 1, jb = tile >> 1, vb = tile & 1;
                const f32x16 z = {0.f, 0.f, 0.f, 0.f, 0.f, 0.f, 0.f, 0.f, 0.f, 0.f, 0.f, 0.f, 0.f, 0.f, 0.f, 0.f};
                const f32x16 acc = mm32(L + L_LAK, 32 * jb, L + L_VVT, 32 * vb, 0, 4, z, lane); st_t_bf16<0>(L + L_X1VT, acc, 32 * jb, 32 * vb, lane);
            }
            __syncthreads();
            { const int tile = w & 3, tb = tile >> 1, cb = tile & 1;
              const f32x16 z = {0.f, 0.f, 0.f, 0.f, 0.f, 0.f, 0.f, 0.f, 0.f, 0.f, 0.f, 0.f, 0.f, 0.f, 0.f, 0.f};
              if (w < 4) { const f32x16 acc = mm32(L + L_TM, 32 * tb, L + L_ACT, 32 * cb, 0, 4, z, lane); st_t_bf16<0>(L + L_WCT, acc, 32 * tb, 32 * cb, lane); }
              else { const f32x16 acc = mm32(L + L_TM, 32 * tb, L + L_X1VT, 32 * cb, 0, 4, z, lane); st_t_bf16<0>(L + L_U0VT, acc, 32 * tb, 32 * cb, lane); }
            }
            __syncthreads();
            { const size_t unit = (size_t)(((bc >> 7) * NH + h) * 128 + (bc & 127));
              unsigned char* cdx = a.ws + WS_CDX + unit * 16384; unsigned char* cdy = a.ws + WS_CDY + unit * 16384;
              const int tile = w & 3, mb = tile >> 1, nb = tile & 1, n = 32 * nb + r;
              const f32x16 z = {0.f, 0.f, 0.f, 0.f, 0.f, 0.f, 0.f, 0.f, 0.f, 0.f, 0.f, 0.f, 0.f, 0.f, 0.f, 0.f};
              if (w < 4) {
                  { const f32x16 acc = mm32(L + L_WCT, 32 * mb, L + L_BHCT, 32 * nb, 0, 4, z, lane);
                    const float gco = GC[(size_t)bc * 512 + h * 64 + n];
#pragma unroll
                    for (int q = 0; q < 4; ++q) { const int i0 = 32 * mb + 8 * q + 4 * hh, p = cpos(i0); float v[4];
#pragma unroll
                        for (int e = 0; e < 4; ++e) v[e] = acc[4 * q + e] + ((i0 + e == n) ? gco : 0.f);
                        v2u o; o.x = pk2(v[0], v[1]); o.y = pk2(v[2], v[3]); *(v2u*)(cdx + (n * 64 + (((p >> 3) ^ (n & 7)) << 3) + (p & 7)) * 2) = o; } }
                  { const f32x16 acc = mm32(L + L_WCT, 32 * mb, L + L_MRB, 32 * nb, 0, 4, z, lane);
#pragma unroll
                    for (int q = 0; q < 4; ++q) { const int i0 = 32 * mb + 8 * q + 4 * hh;
                        const v2u rw = *(LAS const v2u*)(L + L_RTC + n * MS + i0 * 2);
                        const float v0 = acc[4 * q] + bflo(rw.x), v1 = acc[4 * q + 1] + bfhi(rw.x), v2 = acc[4 * q + 2] + bflo(rw.y), v3 = acc[4 * q + 3] + bfhi(rw.y);
                        v2u o; o.x = pk2(v0, v1); o.y = pk2(v2, v3); *(v2u*)(cdy + (n * 64 + i0) * 2) = o; } }
              } else {
                  { f32x16 acc = mm32(L + L_BHCT, 32 * mb, L + L_U0VT, 32 * nb, 0, 4, z, lane); acc = mm32(L + L_KHCT, 32 * mb, L + L_VVT, 32 * nb, 0, 4, acc, lane);
#pragma unroll
                    for (int q = 0; q < 4; ++q) { const int c0 = 32 * mb + 8 * q + 4 * hh; v2u o; o.x = pk2(acc[4 * q], acc[4 * q + 1]); o.y = pk2(acc[4 * q + 2], acc[4 * q + 3]);
                        *(v2u*)(cdx + 8192 + (n * 64 + (((c0 >> 3) ^ (n & 7)) << 3) + (c0 & 7)) * 2) = o; } }
                  { f32x16 acc = mm32(L + L_U0VT, 32 * mb, L + L_MRB, 32 * nb, 0, 4, z, lane); acc = mm32(L + L_VVT, 32 * mb, L + L_MRK, 32 * nb, 0, 4, acc, lane);
#pragma unroll
                    for (int q = 0; q < 4; ++q) { const int v0 = 32 * mb + 8 * q + 4 * hh; v2u o; o.x = pk2(acc[4 * q], acc[4 * q + 1]); o.y = pk2(acc[4 * q + 2], acc[4 * q + 3]);
                        *(v2u*)(cdy + 8192 + (n * 64 + v0) * 2) = o; } }
              }
            }
            __syncthreads();
        }
    }
}
__device__ __forceinline__ void chain_phase(const Args& a, Frame& F, int bh) {
    const int b = bh >> 3, h = bh & 7; (void)b; (void)h;
    const unsigned char* cdx = a.ws + WS_CDX + (size_t)bh * 128 * 16384;
    unsigned char* xs = a.ws + WS_XS + (size_t)bh * 128 * 8192;
    LAS unsigned char* L = F.lds + RING_OFF;
    const int w = F.wave, lane = F.lane;
#define CH_BAR() do { asm volatile("" ::: "memory"); __builtin_amdgcn_s_barrier(); asm volatile("" ::: "memory"); } while (0)
    if (w >= 4) {
        const int lw = w - 4;
#define CH_ISSUE(c) do { const int c_ = (c) < 127 ? (c) : 127; _Pragma("unroll") for (int j = 0; j < 4; ++j) \
            __builtin_amdgcn_global_load_lds((const unsigned*)(cdx + (size_t)c_ * 16384 + (lw * 4 + j) * 1024 + lane * 16), (LAS unsigned*)(L + ((c) & 7) * 16384 + (lw * 4 + j) * 1024), 16, 0, 0); } while (0)
        for (int c = 0; c < 7; ++c) CH_ISSUE(c);
        asm volatile("s_waitcnt vmcnt(24)" ::: "memory");
        CH_BAR();
        for (int n = 0; n < 128; ++n) {
            CH_ISSUE(n + 7);
            asm volatile("s_waitcnt vmcnt(24)" ::: "memory");
            CH_BAR();
        }
        asm volatile("s_waitcnt vmcnt(0)" ::: "memory");
#undef CH_ISSUE
    } else {
        const int v = lane & 15, g = lane >> 4, vr = 16 * w + v;
        f32x4 X[4];
#pragma unroll
        for (int i = 0; i < 4; ++i) X[i] = (f32x4){0.f, 0.f, 0.f, 0.f};
        CH_BAR();
        for (int n = 0; n < 128; ++n) {
            LAS const unsigned char* sl = L + (n & 7) * 16384;
            bf16x8 pt[4][2]; v2u qt[4];
#pragma unroll
            for (int cb = 0; cb < 4; ++cb) { const int o = 16 * cb + v;
#pragma unroll
                for (int ks = 0; ks < 2; ++ks) pt[cb][ks] = *(LAS const bf16x8*)(sl + (o * 64 + (((4 * ks + g) ^ (o & 7)) << 3)) * 2);
                qt[cb] = *(LAS const v2u*)(sl + 8192 + (vr * 64 + (((2 * cb + (g >> 1)) ^ (vr & 7)) << 3) + 4 * (g & 1)) * 2); }
            v4u p[2];
#pragma unroll
            for (int ks = 0; ks < 2; ++ks) { p[ks].x = pg8::cvt_pk_bf16(X[2 * ks][0], X[2 * ks][1]); p[ks].y = pg8::cvt_pk_bf16(X[2 * ks][2], X[2 * ks][3]);
                p[ks].z = pg8::cvt_pk_bf16(X[2 * ks + 1][0], X[2 * ks + 1][1]); p[ks].w = pg8::cvt_pk_bf16(X[2 * ks + 1][2], X[2 * ks + 1][3]); }
#pragma unroll
            for (int cb = 0; cb < 4; ++cb) { f32x4 acc = {bflo(qt[cb].x), bfhi(qt[cb].x), bflo(qt[cb].y), bfhi(qt[cb].y)};
#pragma unroll
                for (int ks = 0; ks < 2; ++ks) acc = __builtin_amdgcn_mfma_f32_16x16x32_bf16(pt[cb][ks], __builtin_bit_cast(bf16x8, p[ks]), acc, 0, 0, 0);
                X[cb] = acc; }
            unsigned char* xo = xs + (size_t)n * 8192 + vr * 128;
#pragma unroll
            for (int ks = 0; ks < 2; ++ks) { *(v2u*)(xo + (32 * ks + 4 * g) * 2) = (v2u){p[ks].x, p[ks].y}; *(v2u*)(xo + (32 * ks + 16 + 4 * g) * 2) = (v2u){p[ks].z, p[ks].w}; }
            CH_BAR();
        }
    }
#undef CH_BAR
}
__device__ __forceinline__ void yfin_units(const Args& a, Frame& F) {
    const bf16* G = (const bf16*)((unsigned char*)a.out + OUT_G); const bf16* BON = (const bf16*)((unsigned char*)a.out + OUT_BON);
    bf16* YA = (bf16*)(a.ws + WS_YA);
    LAS unsigned char* L = F.lds + RING_OFF;
    const int w = F.wave;
    for (int it = F.vcu; it < (M / 64) * 2; it += F.G) {
        int tid = F.tid; asm volatile("" : "+v"(tid));
        const int lane = tid & 63, r = lane & 31, hh = lane >> 5;
        const int bc = it >> 1, hq = it & 1;
#pragma unroll
        for (int k = 0; k < 8; ++k) { const int idx = k * 512 + tid, mat = idx >> 9, within = idx & 511, row = within >> 3, piece = within & 7;
            const int h = 4 * hq + (mat >> 1); const size_t unit = (size_t)(((bc >> 7) * NH + h) * 128 + (bc & 127));
            const unsigned char* src = (mat & 1) ? (a.ws + WS_XS + unit * 8192) : (a.ws + WS_CDY + unit * 16384);
            *(LAS v4u*)(L + mat * MB + row * MS + piece * 16) = *(const v4u*)(src + row * 128 + piece * 16); }
        __syncthreads();
        { const int hl = w >> 1, tt = w & 1, h = 4 * hq + hl; const size_t unit = (size_t)(((bc >> 7) * NH + h) * 128 + (bc & 127));
          const f32x16 z = {0.f, 0.f, 0.f, 0.f, 0.f, 0.f, 0.f, 0.f, 0.f, 0.f, 0.f, 0.f, 0.f, 0.f, 0.f, 0.f};
          LAS const unsigned char* RHl = L + (2 * hl) * MB; LAS const unsigned char* XSl = L + (2 * hl + 1) * MB;
          f32x16 y0a = mm32(XSl, 0, RHl, 32 * tt, 0, 4, z, lane), y1a = mm32(XSl, 32, RHl, 32 * tt, 0, 4, z, lane);
          const int tl = 32 * tt + r; const size_t trow = (size_t)bc * 64 + tl;
          const unsigned char* y0g = a.ws + WS_CDY + unit * 16384 + 8192 + tl * 128;
          float s = 0.f;
#pragma unroll
          for (int q = 0; q < 4; ++q) { const int v0 = 8 * q + 4 * hh;
              const v2u wa = *(const v2u*)(y0g + v0 * 2), wb = *(const v2u*)(y0g + (32 + v0) * 2);
              y0a[4 * q] += bflo(wa.x); y0a[4 * q + 1] += bfhi(wa.x); y0a[4 * q + 2] += bflo(wa.y); y0a[4 * q + 3] += bfhi(wa.y);
              y1a[4 * q] += bflo(wb.x); y1a[4 * q + 1] += bfhi(wb.x); y1a[4 * q + 2] += bflo(wb.y); y1a[4 * q + 3] += bfhi(wb.y); }
#pragma unroll
          for (int i = 0; i < 16; ++i) s += y0a[i] + y1a[i];
          s += __shfl_xor(s, 32);
          const float mean = s * (1.f / 64.f); float qv = 0.f;
#pragma unroll
          for (int i = 0; i < 16; ++i) { const float d0 = y0a[i] - mean, d1 = y1a[i] - mean; qv += d0 * d0 + d1 * d1; }
          qv += __shfl_xor(qv, 32);
          const float rstd = 1.0f / sqrtf(qv * (1.f / 64.f) + 64e-5f);
#pragma unroll
          for (int vt = 0; vt < 2; ++vt)
#pragma unroll
              for (int q = 0; q < 4; ++q) { const int c0 = h * 64 + 32 * vt + 8 * q + 4 * hh; const size_t o = trow * 512 + c0;
                  const f32x4 lg = *(const f32x4*)(a.lnx_g + c0), lb = *(const f32x4*)(a.lnx_b + c0);
                  const v2u bw = *(const v2u*)(BON + o), gw = *(const v2u*)(G + o);
                  float y[4];
#pragma unroll
                  for (int e = 0; e < 4; ++e) y[e] = ((vt ? y1a[4 * q + e] : y0a[4 * q + e]) - mean) * rstd * lg[e] + lb[e];
                  y[0] = (y[0] + bflo(bw.x)) * bflo(gw.x); y[1] = (y[1] + bfhi(bw.x)) * bfhi(gw.x); y[2] = (y[2] + bflo(bw.y)) * bflo(gw.y); y[3] = (y[3] + bfhi(bw.y)) * bfhi(gw.y);
                  v2u ov; ov.x = pk2(y[0], y[1]); ov.y = pk2(y[2], y[3]); *(v2u*)(YA + o) = ov; }
        }
        __syncthreads();
    }
}

__global__ void __launch_bounds__(NWAVES * 64, 2) mega_fwd(Args args) {
    extern __shared__ __attribute__((aligned(16))) unsigned char lds[];
    Frame F;
#define REFRAME() do { int t_ = threadIdx.x; asm volatile("" : "+v"(t_)); F.lds = (LAS unsigned char*)lds; F.MISC = (volatile LAS unsigned*)(F.lds + MISC_OFF); F.tid = t_; F.lane = t_ & 63; \
        F.wave = __builtin_amdgcn_readfirstlane(t_ >> 6); F.G = gridDim.x; { const int bx = blockIdx.x; F.vcu = (F.G % 8 == 0) ? (bx % 8) * (F.G / 8) + bx / 8 : bx; } F.ctl = (gu32*)(args.ws + WS_CTL); } while (0)
    REFRAME();
    unsigned char* ws = args.ws;
    F.ctl = (gu32*)(ws + WS_CTL);
    for (int u = F.tid; u < (LDS_BYTES - LDSCTL_OFF) / 4; u += NWAVES * 64) ((LAS unsigned*)(F.lds + LDSCTL_OFF))[u] = 0u;
    __syncthreads();
    XcdBarrier bar = xcd_barrier_post((unsigned*)(F.ctl + CW_BAR), F.MISC + 8);
#define GB() do { xcd_barrier(bar); REFRAME(); } while (0)
    float* mod = (float*)(ws + WS_MOD);
    bf16* H = (bf16*)(ws + WS_H);
    p0_prologue(args, F); GB();
    rmsnorm_mod_rows(args.x, args.norm1_g, mod, 0, D, H, F); GB();
    { pg8::Gemm g{H, (const bf16*)(ws + WS_WIN), M, IN_PAD, D}; pg8::StaticOrder S; S.init(M, IN_PAD, F.G, (int)blockIdx.x);
      pg8::EpiIn E{(bf16*)(ws + WS_PRKV), (bf16*)(ws + WS_PLORA), (bf16*)(ws + WS_PUV), (bf16*)(ws + WS_SG)};
      pg8::gemm_phase<pg8::EpiIn, pg8::StaticOrder, true, true>(F.lds + RING_OFF, g, S, E); } GB();
    gmlp_units(args, F); GB();
    prep_units(args, F); GB();
    precompute_units(args, F); GB();
    if ((F.vcu & 15) == 0 && F.G == 256) chain_phase(args, F, F.vcu >> 4);
    else { const int nw = F.G == 256 ? 240 : F.G, c = F.G == 256 ? F.vcu - (F.vcu >> 4) - 1 : F.vcu;
      if (F.G != 256 && F.vcu < BATCH * NH) chain_phase(args, F, F.vcu);
      pg8::Gemm g{(const bf16*)(ws + WS_YB), (const bf16*)(ws + WS_WB), M, D, RW}; pg8::StaticOrder S; S.init(M, D, nw, c);
      pg8::EpiGate E{(bf16*)(ws + WS_M1), D, (const bf16*)(ws + WS_SG) + 1024, 2048, nullptr, 0};
      pg8::gemm_phase<pg8::EpiGate, pg8::StaticOrder, true, true>(F.lds + RING_OFF, g, S, E); } GB();
    yfin_units(args, F); GB();
    { pg8::Gemm g{(const bf16*)(ws + WS_YA), (const bf16*)(ws + WS_WA), M, D, RW}; pg8::StaticOrder S; S.init(M, D, F.G, (int)blockIdx.x);
      pg8::EpiGate E{(bf16*)(ws + WS_MERGED), D, (const bf16*)(ws + WS_SG), 2048, (const bf16*)(ws + WS_M1), D};
      pg8::gemm_phase<pg8::EpiGate, pg8::StaticOrder, true, true>(F.lds + RING_OFF, g, S, E); } GB();
    { pg8::Gemm g{(const bf16*)(ws + WS_MERGED), (const bf16*)(ws + WS_WOUT), M, D, D}; pg8::StaticOrder S; S.init(M, D, F.G, (int)blockIdx.x);
      pg8::EpiRes E{args.x, args.out, mod + 2 * D};
      pg8::gemm_phase<pg8::EpiRes, pg8::StaticOrder, true, true>(F.lds + RING_OFF, g, S, E); } GB();
    rmsnorm_mod_rows(args.out, args.norm2_g, mod, 3 * D, 4 * D, (bf16*)(ws + WS_H2), F); GB();
    { pg8::Gemm g{(const bf16*)(ws + WS_H2), (const bf16*)(ws + WS_WFFI), M, 2 * FF, D}; pg8::StaticOrder S; S.init(M, 2 * FF, F.G, (int)blockIdx.x);
      pg8::EpiSwiGLU E{(bf16*)(ws + WS_ACT), FF};
      pg8::gemm_phase<pg8::EpiSwiGLU, pg8::StaticOrder, true, true>(F.lds + RING_OFF, g, S, E); } GB();
    { pg8::Gemm g{(const bf16*)(ws + WS_ACT), (const bf16*)(ws + WS_WFFO), M, D, FF}; pg8::StaticOrder S; S.init(M, D, F.G, (int)blockIdx.x);
      pg8::EpiRes E{args.out, args.out, mod + 5 * D};
      pg8::gemm_phase<pg8::EpiRes, pg8::StaticOrder, true, true>(F.lds + RING_OFF, g, S, E); } GB();
    rmsnorm_final_rows(args.out, args.normf_g, F);
#undef GB
}

extern "C" void kernel_launch(void* const* d_in, const int* in_sizes, int n_in, void* d_out, int out_size, void* d_ws, size_t ws_size, hipStream_t stream) {
    static int grid = 0;
    if (grid == 0) {
        if (n_in != 28 || out_size != M * D || ws_size < WS_END) { fprintf(stderr, "kernel_launch: unexpected shapes (n_in %d out %d ws %zu)\n", n_in, out_size, ws_size); grid = -1; return; }
        int dev = 0, cus = 0, per_cu = 0;
        if (hipGetDevice(&dev) != hipSuccess || hipDeviceGetAttribute(&cus, hipDeviceAttributeMultiprocessorCount, dev) != hipSuccess) { grid = -1; return; }
        if (hipFuncSetAttribute((const void*)mega_fwd, hipFuncAttributeMaxDynamicSharedMemorySize, LDS_BYTES) != hipSuccess) { fprintf(stderr, "kernel_launch: hipFuncSetAttribute failed\n"); grid = -1; return; }
        if (hipOccupancyMaxActiveBlocksPerMultiprocessor(&per_cu, (const void*)mega_fwd, NWAVES * 64, LDS_BYTES) != hipSuccess || per_cu < 1) { fprintf(stderr, "kernel_launch: occupancy query says %d\n", per_cu); per_cu = 1; }
        (void)hipGetLastError();
        grid = cus;
    }
    if (grid < 0) return;
    (void)hipMemsetAsync((char*)d_ws + WS_CTL, 0, CTL_ZERO_BYTES, stream);
    Args a{};
    const float** ap = (const float**)&a;
    for (int i = 0; i < 28; ++i) ap[i] = (const float*)d_in[i];
    a.out = (float*)d_out; a.ws = (unsigned char*)d_ws;
    hipLaunchKernelGGL(mega_fwd, dim3(grid), dim3(NWAVES * 64), LDS_BYTES, stream, a);
}
```
